# Optimizing an MI355X kernel written in HIP

```python
import math
import jax
import jax.numpy as jnp
from jax import lax
import numpy as np

D_MODEL = 1024
BATCH = 8
SEQ = 2048
DEPTH = 1

GDN_HEADS = 8
GDN_HEAD_DIM = 128
GDN_WIDTH = GDN_HEADS * GDN_HEAD_DIM
GDN_CONV = 4
CHUNK = 64
CONV_WIDTH = 1024
SHORT_CONV = 3
MIX_WIDTH = GDN_WIDTH + CONV_WIDTH
EPS = 1e-6

PROJ_SPLITS = (
    3 * GDN_WIDTH,
    GDN_WIDTH,
    GDN_HEADS,
    GDN_HEADS,
    CONV_WIDTH,
    CONV_WIDTH,
    CONV_WIDTH,
    CONV_WIDTH,
)
PROJ_WIDTH = sum(PROJ_SPLITS)

kernel_name = "hybrid_gdn_shortconv_block"


def rmsnorm(x, w):
    xf = x.astype(jnp.float32)
    xf = xf * lax.rsqrt(jnp.mean(xf * xf, axis=-1, keepdims=True) + EPS)
    return (xf * w.astype(jnp.float32)).astype(x.dtype)


def l2norm(x):
    return x * lax.rsqrt(jnp.sum(x * x, axis=-1, keepdims=True) + EPS)


def causal_depthwise_conv(x, w):
    K = w.shape[0]
    L = x.shape[1]
    xp = jnp.pad(x, ((0, 0), (K - 1, 0), (0, 0)))
    return sum(xp[:, j:j + L] * w[j] for j in range(K))


def gated_delta_rule_chunked(q, k, v, g, beta):
    Bsz, L, H, DK = q.shape
    DV = v.shape[-1]
    n = L // CHUNK

    def chunks(t):
        return t.reshape(Bsz, n, CHUNK, H, -1).transpose(0, 3, 1, 2, 4)

    q, k, v = chunks(q), chunks(k), chunks(v)
    g = g.reshape(Bsz, n, CHUNK, H).transpose(0, 3, 1, 2)
    beta = beta.reshape(Bsz, n, CHUNK, H).transpose(0, 3, 1, 2)
    g = jnp.cumsum(g, axis=-1)

    causal = jnp.tril(jnp.ones((CHUNK, CHUNK), dtype=bool))
    strict = jnp.tril(jnp.ones((CHUNK, CHUNK), dtype=bool), k=-1)
    decay = jnp.exp(jnp.where(causal, g[..., :, None] - g[..., None, :], -jnp.inf))

    k_beta = k * beta[..., None]
    v_beta = v * beta[..., None]
    A = jnp.where(strict, jnp.einsum('bhnid,bhnjd->bhnij', k_beta, k) * decay, 0.0)
    eye = jnp.eye(CHUNK, dtype=q.dtype)
    rhs = jnp.concatenate([v_beta, k_beta * jnp.exp(g)[..., None]], axis=-1)
    sol = lax.linalg.triangular_solve(eye + A, rhs, left_side=True, lower=True,
                                      unit_diagonal=True)
    u = sol[..., :DV]
    w = sol[..., DV:]

    attn_intra = jnp.where(causal, jnp.einsum('bhnid,bhnjd->bhnij', q, k) * decay, 0.0)
    g_last = g[..., -1]
    k_state = k * jnp.exp(g_last[..., None] - g)[..., None]
    q_decay = q * jnp.exp(g)[..., None]

    def step(S, inp):
        qd, w_c, u_c, a_c, ks, gl = inp
        v_new = u_c - jnp.einsum('bhck,bhkv->bhcv', w_c, S)
        o = jnp.einsum('bhck,bhkv->bhcv', qd, S) + jnp.einsum('bhij,bhjv->bhiv', a_c, v_new)
        S = S * jnp.exp(gl)[..., None, None] + jnp.einsum('bhck,bhcv->bhkv', ks, v_new)
        return S, o

    xs = tuple(jnp.moveaxis(t, 2, 0) for t in (q_decay, w, u, attn_intra, k_state, g_last))
    S0 = jnp.zeros((Bsz, H, DK, DV), dtype=q.dtype)
    _, o = lax.scan(step, S0, xs)
    return o.transpose(1, 0, 3, 2, 4).reshape(Bsz, L, H, DV)


def hybrid_layer(x, norm_in_w, w_in, conv_qkv_w, A_log, dt_bias, gdn_norm_w,
                 conv_w, conv_b, w_out):
    Bsz, L, _ = x.shape
    h = rmsnorm(x, norm_in_w)
    proj = h @ w_in
    split_at = [int(i) for i in np.cumsum(PROJ_SPLITS)[:-1]]
    qkv, z_g, b_g, a_g, gate_b, gate_c, h_c, z_c = jnp.split(proj, split_at, axis=-1)

    qkv = jax.nn.silu(causal_depthwise_conv(qkv, conv_qkv_w))
    q, k, v = jnp.split(qkv, 3, axis=-1)
    shp = (Bsz, L, GDN_HEADS, GDN_HEAD_DIM)
    q = l2norm(q.reshape(shp).astype(jnp.float32)) * (GDN_HEAD_DIM ** -0.5)
    k = l2norm(k.reshape(shp).astype(jnp.float32))
    v = v.reshape(shp).astype(jnp.float32)
    beta = jax.nn.sigmoid(b_g.astype(jnp.float32))
    g = -jnp.exp(A_log.astype(jnp.float32)) * jax.nn.softplus(
        a_g.astype(jnp.float32) + dt_bias.astype(jnp.float32))
    o = gated_delta_rule_chunked(q, k, v, g, beta).astype(x.dtype)
    o = rmsnorm(o, gdn_norm_w) * jax.nn.silu(z_g.reshape(shp))
    o = o.reshape(Bsz, L, GDN_WIDTH)

    y_c = gate_b * (causal_depthwise_conv(gate_c * h_c, conv_w) + conv_b)
    y_c = y_c * jax.nn.silu(z_c)

    mix = jnp.concatenate([o, y_c], axis=-1)
    return x + mix @ w_out


def setup_inputs(seed: int = 0) -> dict:
    key = jax.random.key(seed)
    ks = jax.random.split(key, 12)
    f32 = jnp.float32
    x = jax.random.normal(ks[0], (BATCH, SEQ, D_MODEL), f32)
    norm_in_w = 1.0 + 0.02 * jax.random.normal(ks[1], (DEPTH, D_MODEL), f32)
    w_in = jax.random.normal(ks[2], (DEPTH, D_MODEL, PROJ_WIDTH), f32) * D_MODEL ** -0.5
    conv_qkv_w = jax.random.normal(ks[3], (DEPTH, GDN_CONV, 3 * GDN_WIDTH), f32) * GDN_CONV ** -0.5
    A_log = jnp.log(jax.random.uniform(ks[4], (DEPTH, GDN_HEADS), f32, minval=1.0, maxval=16.0))
    dt = jnp.exp(jax.random.uniform(ks[5], (DEPTH, GDN_HEADS), f32,
                                    minval=math.log(1e-3), maxval=math.log(1e-1)))
    dt_bias = dt + jnp.log(-jnp.expm1(-dt))
    gdn_norm_w = 1.0 + 0.02 * jax.random.normal(ks[6], (DEPTH, GDN_HEAD_DIM), f32)
    conv_w = jax.random.normal(ks[7], (DEPTH, SHORT_CONV, CONV_WIDTH), f32) * SHORT_CONV ** -0.5
    conv_b = 0.01 * jax.random.normal(ks[8], (DEPTH, CONV_WIDTH), f32)
    w_out = jax.random.normal(ks[9], (DEPTH, MIX_WIDTH, D_MODEL), f32) * MIX_WIDTH ** -0.5
    final_norm_w = 1.0 + 0.02 * jax.random.normal(ks[10], (D_MODEL,), f32)
    return {"x": x, "norm_in_w": norm_in_w, "w_in": w_in, "conv_qkv_w": conv_qkv_w,
            "A_log": A_log, "dt_bias": dt_bias, "gdn_norm_w": gdn_norm_w,
            "conv_w": conv_w, "conv_b": conv_b, "w_out": w_out,
            "final_norm_w": final_norm_w}


def reference(x, norm_in_w, w_in, conv_qkv_w, A_log, dt_bias, gdn_norm_w,
              conv_w, conv_b, w_out, final_norm_w):
    for layer in range(DEPTH):
        x = hybrid_layer(x, norm_in_w[layer], w_in[layer], conv_qkv_w[layer],
                         A_log[layer], dt_bias[layer], gdn_norm_w[layer],
                         conv_w[layer], conv_b[layer], w_out[layer])
    return rmsnorm(x, final_norm_w)
```

```cpp
#include <hip/hip_runtime.h>
#include <hip/hip_cooperative_groups.h>
#include <cstdio>
#include <cstdint>
namespace cg = cooperative_groups;
namespace pg8 {
#define PG8_LAS __attribute__((address_space(3)))
typedef unsigned short bf16_t;
typedef short bf16x8 __attribute__((ext_vector_type(8)));
typedef float f32x4 __attribute__((ext_vector_type(4)));
typedef unsigned u32x4 __attribute__((ext_vector_type(4)));
constexpr int BM = 256, BK = 64, HALF = 128, HTB = HALF * BK * 2  , STAGE_BYTES = 8 * HTB, NXCD = 8, WGM = 8;

__host__ __device__ __forceinline__ int lds_byte(int r, int c) { const int st = (r >> 4) * 2 + (c >> 5), rr = r & 15, cc = c & 31, ob = rr * 64 + cc * 2; return st * 1024 + (ob ^ (((ob >> 9) & 1) << 5)); }
__host__ __device__ __forceinline__ void stage_rc(int b, int& R, int& C) { const int st = b / 1024, sb = b % 1024, swz = sb ^ (((sb >> 9) & 1) << 5); R = (st >> 1) * 16 + swz / 64; C = (st & 1) * 32 + (swz % 64) / 2; }
__host__ __device__ __forceinline__ int perm32(int rho) { const int n = rho >> 4, i = rho & 15; return 8 * (i >> 2) + 4 * n + (i & 3); }

struct Unit { int pm, pn; };
struct Gemm { const bf16_t* A; const bf16_t* Bt; int M, N, K, lda, ksplit; long a2off; };

struct StaticOrder {
    int nM, nN, nwg, G, c;
    __host__ __device__ void init(int M, int N, int G_, int c_) { nM = M / BM; nN = N / BM; nwg = nM * nN; G = G_; c = c_; }
    __host__ __device__ bool next(int i, Unit& u) const {
        const long L = (long)i * G + c; if (L >= nwg) return false;
        int wgid = (int)L; { const int q = nwg / NXCD, r = nwg % NXCD, xcd = wgid % NXCD, off = wgid / NXCD; wgid = (xcd < r ? xcd * (q + 1) : r * (q + 1) + (xcd - r) * q) + off; }
        const int nig = WGM * nN, gid = wgid / nig, fm = gid * WGM, gsz = (nM - fm) < WGM ? (nM - fm) : WGM;
        u.pm = fm + ((wgid % nig) % gsz); u.pn = (wgid % nig) / gsz; return true;
    }
    __device__ __forceinline__ void a_ready(const Unit&) const {}
    __device__ __forceinline__ void done(const Unit&) const {}
};


typedef float f32x2_cv __attribute__((ext_vector_type(2)));
typedef __bf16 bf16x2_cv __attribute__((ext_vector_type(2)));
__device__ __forceinline__ unsigned cvt_pk_bf16_v(float lo, float hi) { f32x2_cv v = {lo, hi}; bf16x2_cv r = __builtin_convertvector(v, bf16x2_cv); return __builtin_bit_cast(unsigned, r); }
__device__ __forceinline__ unsigned cvt_pk_bf16(float lo, float hi) { unsigned r; asm volatile("v_cvt_pk_bf16_f32 %0, %1, %2" : "=v"(r) : "v"(lo), "v"(hi)); return r; }
__device__ __forceinline__ float silu_f(float x) { return x * __builtin_amdgcn_rcpf(1.f + __expf(-x)); }

struct EpiProj {
    static constexpr bool PERM = true, AFTER_DRAIN = false;
    bf16_t* ACT; bf16_t* HALO; size_t actsz;
    __device__ __forceinline__ void operator()(const f32x4 (&acc)[2][2][4][2], const Unit& u, int wr, int wc, int fr, int fq) const {
        const int pn = u.pn, row0 = u.pm * BM + wr * 64 + fr, cw = wc * 32 + 8 * fq;
        if (pn < 16) {
            bf16_t* base = ACT + (size_t)(pn >> 2) * actsz + (pn & 3) * 256 + cw;
            const bool act = pn >= 12, halo = pn < 12;
#pragma unroll
            for (int ai = 0; ai < 2; ++ai)
#pragma unroll
                for (int m = 0; m < 4; ++m) { const int row = row0 + ai * HALF + m * 16; bf16_t* rowp = base + (size_t)row * 1024;
#pragma unroll
                    for (int bj = 0; bj < 2; ++bj) { f32x4 v0 = acc[ai][bj][m][0], v1 = acc[ai][bj][m][1];
                        if (act) {
#pragma unroll
                            for (int j = 0; j < 4; ++j) { v0[j] = silu_f(v0[j]); v1[j] = silu_f(v1[j]); } }
                        u32x4 w; w.x = cvt_pk_bf16_v(v0[0], v0[1]); w.y = cvt_pk_bf16_v(v0[2], v0[3]); w.z = cvt_pk_bf16_v(v1[0], v1[1]); w.w = cvt_pk_bf16_v(v1[2], v1[3]);
                        *(u32x4*)(rowp + bj * HALF) = w;
                        if (m == 3 && halo && fr >= 13) *(u32x4*)(HALO + ((size_t)(row >> 6) * 3 + (fr - 13)) * 3072 + pn * 256 + bj * HALF + cw) = w; } }
        } else {
            const bool kind = pn >= 24; bf16_t* base = ACT + (size_t)(kind ? 5 : 4) * actsz + ((pn - 16) & 7) * 128 + cw;
#pragma unroll
            for (int ai = 0; ai < 2; ++ai)
#pragma unroll
                for (int m = 0; m < 4; ++m) { const int row = row0 + ai * HALF + m * 16;
                    f32x4 a0 = acc[ai][0][m][0], a1 = acc[ai][0][m][1], b0 = acc[ai][1][m][0], b1 = acc[ai][1][m][1];
                    if (kind) {
#pragma unroll
                        for (int j = 0; j < 4; ++j) { b0[j] = silu_f(b0[j]); b1[j] = silu_f(b1[j]); } }
                    a0 = a0 * b0; a1 = a1 * b1;
                    u32x4 w; w.x = cvt_pk_bf16(a0[0], a0[1]); w.y = cvt_pk_bf16(a0[2], a0[3]); w.z = cvt_pk_bf16(a1[0], a1[1]); w.w = cvt_pk_bf16(a1[2], a1[3]);
                    *(u32x4*)(base + (size_t)row * 1024) = w; }
        }
    }
};
struct EpiResNorm {
    static constexpr bool PERM = false, AFTER_DRAIN = true;
    const float* X; float* Y; const float* FW; float* part; unsigned* cnt; int ldc; float eps;
    __device__ __forceinline__ void operator()(const f32x4 (&)[2][2][4][2], const Unit&, int, int, int, int) const {}
    __device__ __forceinline__ void fused(const f32x4 (&acc)[2][2][4][2], const Unit& u, int wr, int wc, int fr, int fq, PG8_LAS unsigned char* lds, int wid, int lane) const {
        PG8_LAS float* red = (PG8_LAS float*)lds;
        PG8_LAS float* rs = (PG8_LAS float*)(lds + 4096);
        const int row0 = u.pm * BM + wr * 64 + fr, col0 = u.pn * BM + wc * 32 + 4 * fq; int tid = threadIdx.x; asm volatile("" : "+v"(tid));
#pragma unroll
        for (int ai = 0; ai < 2; ++ai)
#pragma unroll
            for (int m = 0; m < 4; ++m) { const size_t o = (size_t)(row0 + ai * HALF + m * 16) * ldc + col0; float ss = 0.f;
#pragma unroll
                for (int bj = 0; bj < 2; ++bj)
#pragma unroll
                    for (int n = 0; n < 2; ++n) { const f32x4 y = acc[ai][bj][m][n] + *(const f32x4*)(X + o + bj * HALF + n * 16); ss += (y.x * y.x + y.y * y.y) + (y.z * y.z + y.w * y.w); }
                ss += __shfl_xor(ss, 16); ss += __shfl_xor(ss, 32);
                if (fq == 0) red[((wr * 4 + wc) * 8 + ai * 4 + m) * 16 + fr] = ss; }
        __syncthreads();
        if (tid < 256) { const int w_ = (tid >> 6) & 1, ai = tid >> 7, m = (tid >> 4) & 3, f = tid & 15; float s = 0.f;
#pragma unroll
            for (int c = 0; c < 4; ++c) s += red[((w_ * 4 + c) * 8 + ai * 4 + m) * 16 + f];
            __hip_atomic_store(part + (size_t)(u.pm * BM + tid) * 4 + u.pn, s, __ATOMIC_RELAXED, __HIP_MEMORY_SCOPE_AGENT); }
        asm volatile("s_waitcnt vmcnt(0)" ::: "memory");
        __syncthreads();
        if (tid == 0) { __hip_atomic_fetch_add(cnt + 16 * u.pm, 1u, __ATOMIC_RELAXED, __HIP_MEMORY_SCOPE_AGENT);
            while (__hip_atomic_load(cnt + 16 * u.pm, __ATOMIC_RELAXED, __HIP_MEMORY_SCOPE_AGENT) < 4u) __builtin_amdgcn_s_sleep(2); }
        __syncthreads();
        if (tid < 256) { const float* pp = part + (size_t)(u.pm * BM + tid) * 4; float s = 0.f;
#pragma unroll
            for (int c = 0; c < 4; ++c) s += __hip_atomic_load(pp + c, __ATOMIC_RELAXED, __HIP_MEMORY_SCOPE_AGENT);
            rs[tid] = 1.f / sqrtf(s * (1.f / 1024.f) + eps); }
        __syncthreads();
        f32x4 fw[2][2];
#pragma unroll
        for (int bj = 0; bj < 2; ++bj)
#pragma unroll
            for (int n = 0; n < 2; ++n) fw[bj][n] = *(const f32x4*)(FW + col0 + bj * HALF + n * 16);
#pragma unroll
        for (int ai = 0; ai < 2; ++ai)
#pragma unroll
            for (int m = 0; m < 4; ++m) { const size_t o = (size_t)(row0 + ai * HALF + m * 16) * ldc + col0; const float rstd = rs[ai * HALF + wr * 64 + m * 16 + fr];
#pragma unroll
                for (int bj = 0; bj < 2; ++bj)
#pragma unroll
                    for (int n = 0; n < 2; ++n) { const f32x4 y = acc[ai][bj][m][n] + *(const f32x4*)(X + o + bj * HALF + n * 16); *(f32x4*)(Y + o + bj * HALF + n * 16) = y * rstd * fw[bj][n]; } }
    }
};
struct EpiRes {
    static constexpr bool PERM = false, AFTER_DRAIN = false;
    const float* X; float* Y; int ldc;
    __device__ __forceinline__ void operator()(const f32x4 (&acc)[2][2][4][2], const Unit& u, int wr, int wc, int fr, int fq) const {
        const int row0 = u.pm * BM + wr * 64 + fr, col0 = u.pn * BM + wc * 32 + 4 * fq;
#pragma unroll
        for (int ai = 0; ai < 2; ++ai)
#pragma unroll
            for (int m = 0; m < 4; ++m) { const size_t o = (size_t)(row0 + ai * HALF + m * 16) * ldc + col0;
#pragma unroll
                for (int bj = 0; bj < 2; ++bj)
#pragma unroll
                    for (int n = 0; n < 2; ++n) *(f32x4*)(Y + o + bj * HALF + n * 16) = acc[ai][bj][m][n] + *(const f32x4*)(X + o + bj * HALF + n * 16); }
    }
};

template <class Epi, class Sched, bool ALIGN_EPI = false, bool SP2 = false>
__device__ __forceinline__ void gemm_phase(PG8_LAS unsigned char* lds, const Gemm g, const Sched& S, const Epi& E) {
    const int tid = threadIdx.x, wid = __builtin_amdgcn_readfirstlane(tid >> 6), lane = tid & 63, wr = wid >> 2, wc = wid & 3, fr = lane & 15, fq = lane >> 4;
    const int K = g.K, nt = K / BK, lda = g.lda, ksplit = g.ksplit; const long a2off = g.a2off;
    unsigned voffA[2], voffB[2];
#pragma unroll
    for (int i = 0; i < 2; ++i) { int R, C; stage_rc(tid * 16 + i * 8192, R, C); const int Rb = Epi::PERM ? ((R & ~31) + perm32(R & 31)) : R;
        voffA[i] = (unsigned)(R * lda + C) * 2u; voffB[i] = (unsigned)(Rb * K + C) * 2u; }
    const size_t kstep = (size_t)(BK * 2);
    const size_t hstep = (size_t)HALF * K * 2;
    const size_t tstep = 2 * hstep; const size_t hstepA = (size_t)HALF * lda * 2, tstepA = 2 * hstepA;
#define PG8_AK(base, t) ((base) + (((t) < ksplit) ? (long)(t) * (long)kstep : a2off + (long)((t) - ksplit) * (long)kstep))
    const unsigned ldsw = (unsigned)wid * 1024u;
    const int aoff = lds_byte(wr * 64 + fr, fq * 8), boff = lds_byte(wc * 32 + fr, fq * 8);
#define PG8_SA(b, h) (((b) * 2 + (h)) * HTB)
#define PG8_SB(b, h) ((4 + (b) * 2 + (h)) * HTB)
#define PG8_STAGE(bufoff, gbase, voff) do { _Pragma("unroll") for (int _i = 0; _i < 2; ++_i) \
        __builtin_amdgcn_global_load_lds((const unsigned*)((const char*)(gbase) + (voff)[_i]), (PG8_LAS unsigned*)(lds + (bufoff) + ldsw + _i * 8192), 16, 0, 0); } while (0)
#define PG8_LDA(dst, b, h) do { _Pragma("unroll") for (int m = 0; m < 4; ++m) _Pragma("unroll") for (int k = 0; k < 2; ++k) dst[m][k] = *(const PG8_LAS bf16x8*)(lds + PG8_SA(b, h) + aoff + m * 2048 + k * 1024); } while (0)
#define PG8_LDB(dst, b, h) do { _Pragma("unroll") for (int n = 0; n < 2; ++n) _Pragma("unroll") for (int k = 0; k < 2; ++k) dst[n][k] = *(const PG8_LAS bf16x8*)(lds + PG8_SB(b, h) + boff + n * 2048 + k * 1024); } while (0)
#define PG8_MMA(ai, bj, At, Bt) do { __builtin_amdgcn_s_setprio(1); _Pragma("unroll") for (int m = 0; m < 4; ++m) _Pragma("unroll") for (int n = 0; n < 2; ++n) _Pragma("unroll") for (int k = 0; k < 2; ++k) \
        acc[ai][bj][m][n] = __builtin_amdgcn_mfma_f32_16x16x32_bf16(Bt[n][k], At[m][k], acc[ai][bj][m][n], 0, 0, 0); __builtin_amdgcn_s_setprio(0); } while (0)
#define PG8_WAIT_V(n) asm volatile("s_waitcnt vmcnt(" #n ")" ::: "memory")
#define PG8_WAIT_L(n) asm volatile("s_waitcnt lgkmcnt(" #n ")" ::: "memory")
#define PG8_BAR __builtin_amdgcn_s_barrier()
#define PG8_SCHED __builtin_amdgcn_sched_barrier(0)
    Unit cur, nxt; int ui = 0;
    if (!S.next(0, cur)) return;
    f32x4 acc[2][2][4][2];
#pragma unroll
    for (int a = 0; a < 2; ++a)
#pragma unroll
        for (int b = 0; b < 2; ++b)
#pragma unroll
            for (int m = 0; m < 4; ++m)
#pragma unroll
                for (int n = 0; n < 2; ++n) acc[a][b][m][n] = (f32x4){0.f, 0.f, 0.f, 0.f};
    bf16x8 At[4][2], B0[2][2], B1[2][2];
    const char* cA = (const char*)g.A + (size_t)cur.pm * tstepA; const char* cB = (const char*)g.Bt + (size_t)cur.pn * tstep;
    S.a_ready(cur);
    if constexpr (SP2) {
        PG8_STAGE(PG8_SB(0, 0), cB, voffB); PG8_STAGE(PG8_SB(0, 1), cB + hstep, voffB); PG8_STAGE(PG8_SA(0, 0), cA, voffA); PG8_STAGE(PG8_SA(0, 1), cA + hstepA, voffA);
        if (wr == 1) PG8_BAR;
        PG8_WAIT_V(2); PG8_BAR;
        PG8_STAGE(PG8_SB(1, 0), cB + kstep, voffB); PG8_STAGE(PG8_SA(1, 0), cA + kstep, voffA); PG8_STAGE(PG8_SB(1, 1), cB + hstep + kstep, voffB);
        PG8_WAIT_V(6); PG8_BAR;
    } else {
        PG8_STAGE(PG8_SB(0, 0), cB, voffB); PG8_STAGE(PG8_SA(0, 0), cA, voffA); PG8_STAGE(PG8_SB(0, 1), cB + hstep, voffB); PG8_STAGE(PG8_SA(0, 1), cA + hstepA, voffA);
        if (wr == 1) PG8_BAR;
        PG8_WAIT_V(4); PG8_BAR;
        PG8_STAGE(PG8_SB(1, 0), cB + kstep, voffB); PG8_STAGE(PG8_SA(1, 0), cA + kstep, voffA); PG8_STAGE(PG8_SB(1, 1), cB + hstep + kstep, voffB);
        PG8_WAIT_V(6); PG8_BAR;
    }
    for (;;) {
        const bool has_next = S.next(ui + 1, nxt);
        const char* nA = has_next ? (const char*)g.A + (size_t)nxt.pm * tstepA : cA; const char* nB = has_next ? (const char*)g.Bt + (size_t)nxt.pn * tstep : cB;
        for (int t = 0; t < nt; t += 2) {
            const bool last = (t == nt - 2);
            const char* a1 = PG8_AK(cA, t + 1);
            const char* a2 = last ? nA : PG8_AK(cA, t + 2); const char* b2 = last ? nB : cB + (size_t)(t + 2) * kstep;
            const char* a3 = last ? nA + kstep : PG8_AK(cA, t + 3); const char* b3 = b2 + kstep;
            if (last && has_next) S.a_ready(nxt);
            if constexpr (SP2) {
            PG8_LDB(B0, 0, 0); PG8_LDB(B1, 0, 1); PG8_SCHED; PG8_LDA(At, 0, 0); PG8_STAGE(PG8_SA(1, 1), a1 + hstepA, voffA);
            PG8_WAIT_V(8); PG8_WAIT_L(0); PG8_BAR; PG8_MMA(0, 0, At, B0); PG8_MMA(0, 1, At, B1); PG8_BAR; PG8_SCHED;
            PG8_LDA(At, 0, 1); PG8_STAGE(PG8_SB(0, 0), b2, voffB); PG8_STAGE(PG8_SB(0, 1), b2 + hstep, voffB); PG8_STAGE(PG8_SA(0, 0), a2, voffA);
            PG8_WAIT_V(8); PG8_WAIT_L(0); PG8_BAR; PG8_MMA(1, 0, At, B0); PG8_MMA(1, 1, At, B1); PG8_BAR; PG8_SCHED;
            PG8_LDB(B0, 1, 0); PG8_LDB(B1, 1, 1); PG8_SCHED; PG8_LDA(At, 1, 0); PG8_STAGE(PG8_SA(0, 1), a2 + hstepA, voffA);
            PG8_WAIT_V(8); PG8_WAIT_L(0); PG8_BAR; PG8_MMA(0, 0, At, B0); PG8_MMA(0, 1, At, B1); PG8_BAR; PG8_SCHED;
            PG8_LDA(At, 1, 1); PG8_STAGE(PG8_SB(1, 0), b3, voffB); PG8_STAGE(PG8_SB(1, 1), b3 + hstep, voffB); PG8_STAGE(PG8_SA(1, 0), a3, voffA);
            PG8_WAIT_V(8); PG8_WAIT_L(0); PG8_BAR; PG8_MMA(1, 0, At, B0); PG8_MMA(1, 1, At, B1); PG8_BAR; PG8_SCHED;
            } else {
            PG8_LDB(B0, 0, 0); PG8_SCHED; PG8_LDA(At, 0, 0); PG8_STAGE(PG8_SA(1, 1), a1 + hstepA, voffA);
            PG8_WAIT_L(8); PG8_BAR; PG8_WAIT_L(0); PG8_MMA(0, 0, At, B0); PG8_BAR; PG8_SCHED;
            PG8_LDB(B1, 0, 1); PG8_STAGE(PG8_SB(0, 0), b2, voffB);
            PG8_BAR; PG8_WAIT_L(0); PG8_MMA(0, 1, At, B1); PG8_BAR;
            PG8_LDA(At, 0, 1); PG8_STAGE(PG8_SA(0, 0), a2, voffA);
            PG8_BAR; PG8_WAIT_L(0); PG8_MMA(1, 0, At, B0); PG8_BAR; PG8_SCHED;
            PG8_STAGE(PG8_SB(0, 1), b2 + hstep, voffB);
            PG8_WAIT_V(6); PG8_BAR; PG8_MMA(1, 1, At, B1); PG8_BAR;
            PG8_LDB(B0, 1, 0); PG8_SCHED; PG8_LDA(At, 1, 0); PG8_STAGE(PG8_SA(0, 1), a2 + hstepA, voffA);
            PG8_WAIT_L(8); PG8_BAR; PG8_WAIT_L(0); PG8_MMA(0, 0, At, B0); PG8_BAR; PG8_SCHED;
            PG8_LDB(B1, 1, 1); PG8_STAGE(PG8_SB(1, 0), b3, voffB);
            PG8_BAR; PG8_WAIT_L(0); PG8_MMA(0, 1, At, B1); PG8_BAR;
            PG8_LDA(At, 1, 1); PG8_STAGE(PG8_SA(1, 0), a3, voffA);
            PG8_BAR; PG8_WAIT_L(0); PG8_MMA(1, 0, At, B0); PG8_BAR; PG8_SCHED;
            PG8_STAGE(PG8_SB(1, 1), b3 + hstep, voffB);
            PG8_WAIT_V(6); PG8_BAR; PG8_MMA(1, 1, At, B1); PG8_BAR;
            }
        }
        if constexpr (ALIGN_EPI) { if (wr == 0) PG8_BAR; }
        if constexpr (!Epi::AFTER_DRAIN) { E(acc, cur, wr, wc, fr, fq); S.done(cur); }
        if (!has_next) break;
#pragma unroll
        for (int a = 0; a < 2; ++a)
#pragma unroll
            for (int b = 0; b < 2; ++b)
#pragma unroll
                for (int m = 0; m < 4; ++m)
#pragma unroll
                    for (int n = 0; n < 2; ++n) acc[a][b][m][n] = (f32x4){0.f, 0.f, 0.f, 0.f};
        cur = nxt; cA = nA; cB = nB; ++ui;
        if constexpr (ALIGN_EPI) { if (wr == 1) PG8_BAR; }
    }
    PG8_WAIT_V(0);
    if constexpr (!ALIGN_EPI) { if (wr == 0) PG8_BAR; }
    PG8_BAR;
    if constexpr (Epi::AFTER_DRAIN) { E.fused(acc, cur, wr, wc, fr, fq, lds, wid, lane); S.done(cur); }
#undef PG8_AK
#undef PG8_SA
#undef PG8_SB
#undef PG8_STAGE
#undef PG8_LDA
#undef PG8_LDB
#undef PG8_MMA
#undef PG8_WAIT_V
#undef PG8_WAIT_L
#undef PG8_BAR
#undef PG8_SCHED
}
}


constexpr int BATCH = 8, T = 2048, D = 1024, M = BATCH * T, NH = 8, HD = 128, PW = 8208, N1 = 8192, KMIX = 2048, CH = 64, NCH = T / CH;
constexpr int NITEM = BATCH * NCH * NH;
constexpr float EPS = 1e-6f;
constexpr int NWAVES = 8;
constexpr size_t MiB = 1u << 20;
constexpr size_t WS_WIN = 1 * MiB;
constexpr size_t WS_WOUT = 17 * MiB;
constexpr size_t WS_G = 21 * MiB;
constexpr size_t WS_BETA = WS_G + 512 * 1024;
constexpr size_t WS_HALO = 22 * MiB;
constexpr size_t WS_EGL = 27 * MiB;
constexpr size_t WS_SSQ = 28 * MiB;
constexpr size_t WS_HB = 32 * MiB;
constexpr size_t WS_ACT = 64 * MiB;
constexpr size_t ACTSZ = (size_t)M * 1024;
constexpr size_t WS_END = 256 * MiB;
static_assert(WS_ACT + 6 * ACTSZ * 2 == WS_END, "ws map");
constexpr int LDS_BYTES = 147456;

#define LAS __attribute__((address_space(3)))
#define DI __device__ __forceinline__
typedef unsigned short bf16;
typedef unsigned v4u __attribute__((ext_vector_type(4)));
typedef unsigned v2u __attribute__((ext_vector_type(2)));
typedef float f32x4 __attribute__((ext_vector_type(4)));
typedef float f32x2 __attribute__((ext_vector_type(2)));
typedef short bf16x8 __attribute__((ext_vector_type(8)));
using pg8::cvt_pk_bf16;
using pg8::cvt_pk_bf16_v;
using pg8::silu_f;
DI float bf_lo(unsigned u) { return __uint_as_float(u << 16); }
DI float bf_hi(unsigned u) { return __uint_as_float(u & 0xffff0000u); }
#define DPP_MOV(x, ctrl) __int_as_float(__builtin_amdgcn_mov_dpp(__float_as_int(x), (ctrl), 0xF, 0xF, true))
#define DPP_UPD0(x, ctrl, rmask) __int_as_float(__builtin_amdgcn_update_dpp(0, __float_as_int(x), (ctrl), (rmask), 0xF, false))
DI float row16_sum(float v) { v += DPP_MOV(v, 0xB1); v += DPP_MOV(v, 0x4E); v += DPP_MOV(v, 0x141); v += DPP_MOV(v, 0x140); return v; }
DI float wave_sum(float v) {
    v = row16_sum(v);
    v += DPP_UPD0(v, 0x142, 0xA);
    v += DPP_UPD0(v, 0x143, 0xC);
    return __int_as_float(__builtin_amdgcn_readlane(__float_as_int(v), 63));
}
DI int posf(int idx) { return (idx & ~31) | (((idx >> 2) & 3) << 3) | (((idx >> 4) & 1) << 2) | (idx & 3); }
constexpr int permf(int p) { return (p & ~31) | (((p >> 2) & 1) << 4) | (((p >> 3) & 3) << 2) | (p & 3); }
#define LDSV(T, name, src) unsigned name##_u = (unsigned)(size_t)(src); asm volatile("" : "+v"(name##_u)); T name = (T)name##_u
#ifndef DBG_NO_HALO
#define DBG_NO_HALO 0
#endif
#define MFMA16(a, b, c) __builtin_amdgcn_mfma_f32_16x16x32_bf16((a), (b), (c), 0, 0, 0)

struct Args { const float* in[11]; float* out; unsigned char* ws; };

#define XB_TMO      128
#define XB_XCNT(j)  (256  + 64 * (j))
#define XB_XSUB(j)  (1280 + 64 * (j))
#define XB_XGEN(j)  (2304 + 64 * (j))
#define XB_TOP      3328
#define XB_TOPGEN   3392
#define XCD_BAR_WORDS 3456
#define XB_SPIN_CAP (1u << 18)

__device__ __forceinline__ unsigned xb_ld(unsigned* p)              { return __hip_atomic_load(p, __ATOMIC_RELAXED, __HIP_MEMORY_SCOPE_AGENT); }
__device__ __forceinline__ unsigned xb_add(unsigned* p, unsigned v) { return __hip_atomic_fetch_add(p, v, __ATOMIC_RELAXED, __HIP_MEMORY_SCOPE_AGENT); }
__device__ __forceinline__ unsigned xb_xcc_id() { return (unsigned)__builtin_amdgcn_s_getreg((3 << 11) | 20) & 0xFu; }
#define XB_SPIN(cond, bar) do { unsigned _sp = 0; while (cond) { __builtin_amdgcn_s_sleep(1); \
    if ((++_sp & 255u) == 0u) { if (xb_ld(&(bar)[XB_TMO])) break; if (_sp > XB_SPIN_CAP) { atomicAdd(&(bar)[XB_TMO], 1u); break; } } } } while (0)

struct XcdBarrier {
    unsigned* bar; unsigned x;
    volatile LAS unsigned* st;
};

__device__ __forceinline__ XcdBarrier xcd_barrier_post(unsigned* bar, volatile LAS unsigned* st) {
    XcdBarrier b; b.bar = bar; b.x = xb_xcc_id(); b.st = st;
    if (threadIdx.x == 0) (void)xb_add(&bar[XB_XCNT(b.x)], 1u);
    return b;
}
__device__ __forceinline__ void xcd_barrier_complete(unsigned* bar, unsigned x, unsigned& nloc, unsigned& nx) {
    const unsigned G = gridDim.x * gridDim.y * gridDim.z;
    unsigned sum, cnt, mine, sp = 0u;
    for (;;) {
        sum = 0u; cnt = 0u; mine = 0u;
#pragma unroll
        for (unsigned j = 0; j < 16; ++j) { const unsigned c = xb_ld(&bar[XB_XCNT(j)]); sum += c; cnt += (c > 0u) ? 1u : 0u; mine = (j == x) ? c : mine; }
        if (sum == G) break;
        __builtin_amdgcn_s_sleep(1);
        if ((++sp & 255u) == 0u) { if (xb_ld(&bar[XB_TMO])) break; if (sp > XB_SPIN_CAP) { atomicAdd(&bar[XB_TMO], 1u); break; } }
    }
    nloc = mine > 0u ? mine : 1u; nx = cnt > 0u ? cnt : 1u;
}

__device__ __forceinline__ void xcd_barrier(const XcdBarrier& b) {
    asm volatile("s_waitcnt vmcnt(0)" ::: "memory");
    __syncthreads();
    if (threadIdx.x == 0) {
        unsigned* bar = b.bar;
        __builtin_amdgcn_s_waitcnt(0);
        unsigned nloc = b.st[0], nx = b.st[1];
        if (nloc == 0u) { xcd_barrier_complete(bar, b.x, nloc, nx); b.st[0] = nloc; b.st[1] = nx; }
        const unsigned old = xb_add(&bar[XB_XSUB(b.x)], 1u);
        const unsigned gen = old / nloc;
        if (old + 1u == (gen + 1u) * nloc) {
            __builtin_amdgcn_fence(__ATOMIC_RELEASE, "agent");
            asm volatile("s_waitcnt vmcnt(0)" ::: "memory");
            const unsigned og = xb_add(&bar[XB_TOP], 1u);
            const unsigned tg = og / nx;
            if (og + 1u == (tg + 1u) * nx) xb_add(&bar[XB_TOPGEN], 1u);
            else XB_SPIN(xb_ld(&bar[XB_TOPGEN]) == tg, bar);
            __builtin_amdgcn_fence(__ATOMIC_ACQUIRE, "agent");
            xb_add(&bar[XB_XGEN(b.x)], 1u);
            asm volatile("s_waitcnt vmcnt(0)" ::: "memory");
        } else {
            XB_SPIN(xb_ld(&bar[XB_XGEN(b.x)]) == gen, bar);
            __builtin_amdgcn_fence(__ATOMIC_ACQUIRE, "agent");
            asm volatile("s_waitcnt vmcnt(0)" ::: "memory");
        }
    }
    __syncthreads();
}


DI int srccol(int n0) {
    if (n0 < 4096) return n0;
    if (n0 < 6144) { const int r = n0 - 4096, tau = r >> 8, w = r & 255; return w < 128 ? 5136 + 128 * tau + w : 6160 + 128 * tau + (w - 128); }
    const int r = n0 - 6144, tau = r >> 8, w = r & 255; return w < 128 ? 4112 + 128 * tau + w : 7184 + 128 * tau + (w - 128);
}
DI void transpose_item(const float* W, int ldw, int srccol0, bf16* WT, int K, int n0, int k0, LAS float* scr, int lane) {
    f32x4 ld[8];
#pragma unroll
    for (int i = 0; i < 8; ++i) { const int pc = lane + 64 * i, kk = pc >> 3, n4 = pc & 7; ld[i] = *(const f32x4*)(W + (size_t)(k0 + kk) * ldw + srccol0 + 4 * n4); }
#pragma unroll
    for (int i = 0; i < 8; ++i) { const int pc = lane + 64 * i, kk = pc >> 3, n4 = pc & 7; LAS float* d = scr + kk * 33 + 4 * n4; d[0] = ld[i].x; d[1] = ld[i].y; d[2] = ld[i].z; d[3] = ld[i].w; }
    asm volatile("s_waitcnt lgkmcnt(0)" ::: "memory");
    const int c = lane & 7;
#pragma unroll
    for (int j = 0; j < 4; ++j) { const int n = (lane >> 3) + 8 * j; const LAS float* s = scr + (8 * c) * 33 + n;
        v4u o; o.x = cvt_pk_bf16(s[0 * 33], s[1 * 33]); o.y = cvt_pk_bf16(s[2 * 33], s[3 * 33]); o.z = cvt_pk_bf16(s[4 * 33], s[5 * 33]); o.w = cvt_pk_bf16(s[6 * 33], s[7 * 33]);
        *(v4u*)(WT + (size_t)(n0 + n) * K + k0 + 8 * c) = o; }
    asm volatile("s_waitcnt lgkmcnt(0)" ::: "memory");
}
DI void p0_prologue(const Args& a, LAS unsigned char* lds, int vcu, int G, int tid, int lane, int wave) {
    unsigned char* ws = a.ws;
    const float* x = a.in[0]; const float* norm_w = a.in[1]; const float* w_in = a.in[2]; const float* A_log = a.in[4]; const float* dt_bias = a.in[5]; const float* w_out = a.in[9];
    bf16* WinT = (bf16*)(ws + WS_WIN); bf16* WoutT = (bf16*)(ws + WS_WOUT); bf16* HB = (bf16*)(ws + WS_HB);
    float* Gb = (float*)(ws + WS_G); float* Bb = (float*)(ws + WS_BETA);
    LAS float* scr = (LAS float*)(lds + wave * 16384);
    const int gw = vcu * NWAVES + wave, NGW = G * NWAVES;
    constexpr int I_IN = (D / 64) * (N1 / 32), I_OUT = (KMIX / 64) * (D / 32);
#define P0_LOAD(dst, mb) do { _Pragma("unroll") for (int u = 0; u < 4; ++u) { const f32x4* xr_ = (const f32x4*)(x + (size_t)min((mb) + u * NGW, M - 1) * D) + lane; \
        _Pragma("unroll") for (int j = 0; j < 4; ++j) dst[u][j] = xr_[64 * j]; } } while (0)
    f32x4 vv[4][4], vnx[4][4];
    P0_LOAD(vv, gw);
    for (int it = gw; it < I_IN + I_OUT; it += NGW) {
        if (it < I_IN) { const int kb = it / (N1 / 32), nb = it % (N1 / 32); transpose_item(w_in, PW, srccol(32 * nb), WinT, D, 32 * nb, 64 * kb, scr, lane); }
        else { const int r = it - I_IN, kb = r / (D / 32), nb = r % (D / 32); transpose_item(w_out, D, 32 * nb, WoutT, KMIX, 32 * nb, 64 * kb, scr, lane); }
    }
    __syncthreads();
    LAS float* wbg = (LAS float*)lds;
    {   float tmpw[32];
#pragma unroll
        for (int i = 0; i < 32; ++i) { const int idx = tid + 512 * i, k = idx >> 4, c = idx & 15; tmpw[i] = w_in[(size_t)k * PW + 4096 + c]; }
#pragma unroll
        for (int i = 0; i < 32; ++i) { const int idx = tid + 512 * i, k = idx >> 4, c = idx & 15; wbg[c * 1024 + k] = tmpw[i]; } }
    __syncthreads();
    const LAS f32x4* wb4 = (const LAS f32x4*)wbg;
    f32x4 nw[4];
#pragma unroll
    for (int j = 0; j < 4; ++j) nw[j] = ((const f32x4*)norm_w)[lane + 64 * j];
    for (int m0 = gw; m0 < M; m0 += 4 * NGW) {
        int mr[4];
#pragma unroll
        for (int u = 0; u < 4; ++u) mr[u] = min(m0 + u * NGW, M - 1);
        if (m0 + 4 * NGW < M) P0_LOAD(vnx, m0 + 4 * NGW);
#pragma unroll
        for (int u = 0; u < 4; ++u) { float s = 0.f;
#pragma unroll
            for (int j = 0; j < 4; ++j) s += (vv[u][j].x * vv[u][j].x + vv[u][j].y * vv[u][j].y) + (vv[u][j].z * vv[u][j].z + vv[u][j].w * vv[u][j].w);
            const float rstd = __builtin_amdgcn_rsqf(wave_sum(s) * (1.f / D) + EPS);
            unsigned long long* o8 = (unsigned long long*)(HB + (size_t)mr[u] * D) + lane;
#pragma unroll
            for (int j = 0; j < 4; ++j) { vv[u][j] = vv[u][j] * rstd * nw[j];
                o8[64 * j] = (unsigned long long)cvt_pk_bf16(vv[u][j].x, vv[u][j].y) | ((unsigned long long)cvt_pk_bf16(vv[u][j].z, vv[u][j].w) << 32); } }
        float ds[64];
#pragma unroll
        for (int c = 0; c < 16; ++c) { f32x2 d2[4] = {{0.f, 0.f}, {0.f, 0.f}, {0.f, 0.f}, {0.f, 0.f}};
#pragma unroll
            for (int j = 0; j < 4; ++j) { const f32x4 w = wb4[c * 256 + lane + 64 * j]; const f32x2 w01 = {w.x, w.y}, w23 = {w.z, w.w};
#pragma unroll
                for (int u = 0; u < 4; ++u) { d2[u] = d2[u] + (f32x2){vv[u][j].x, vv[u][j].y} * w01; d2[u] = d2[u] + (f32x2){vv[u][j].z, vv[u][j].w} * w23; } }
#pragma unroll
            for (int u = 0; u < 4; ++u) ds[16 * u + c] = d2[u].x + d2[u].y; }
#pragma unroll
        for (int o = 32; o >= 1; o >>= 1) { const bool up = (lane & o) != 0;
#pragma unroll
            for (int k = 0; k < o; ++k) { const float lo = ds[k], hi = ds[k + o]; const float send = up ? lo : hi, keep = up ? hi : lo; ds[k] = keep + __shfl_xor(send, o); } }
        {   const float sel = ds[0]; const int u = lane >> 4, c = lane & 15; const int m = (u == 0) ? mr[0] : (u == 1 ? mr[1] : (u == 2 ? mr[2] : mr[3]));
            if (c < 8) Bb[(size_t)m * 8 + c] = 1.f / (1.f + expf(-sel));
            else { const int h = c - 8; const float xx = sel + dt_bias[h]; const float sp = fmaxf(xx, 0.f) + log1pf(expf(-fabsf(xx))); Gb[(size_t)m * 8 + h] = -expf(A_log[h]) * sp; } }
#pragma unroll
        for (int u = 0; u < 4; ++u)
#pragma unroll
            for (int j = 0; j < 4; ++j) vv[u][j] = vnx[u][j];
    }
#undef P0_LOAD
}

constexpr int KN_STRIDE = 136;
constexpr int AT_STRIDE = 68;
constexpr int PA_KN = 0, PA_QN = 64 * KN_STRIDE * 2, PA_AT = 2 * PA_QN, PA_VH = PA_AT + 64 * AT_STRIDE * 4, PA_SM = PA_VH + 64 * KN_STRIDE * 2, PA_ITEM_LDS = PA_SM + 1024;
static_assert(2 * PA_ITEM_LDS <= LDS_BYTES, "PA LDS");

DI void tri_solve(f32x2 (&X)[64], const LAS float* A) {
#ifdef DBG_NO_SOLVE
    return;
#endif
    const unsigned a_u = (unsigned)(size_t)A;
#pragma unroll
    for (int i = 1; i < 64; ++i) {
        unsigned ai = a_u + i * AT_STRIDE * 4;
        asm volatile("" : "+v"(ai) : "v"(X[(i < 32) ? (i >= 2 ? i - 2 : 0) : i - 1].x));
        const LAS float* rowp = (const LAS float*)ai;
        f32x2 acc[4] = {X[i], {0.f, 0.f}, {0.f, 0.f}, {0.f, 0.f}};
#pragma unroll
        for (int j4 = 0; 4 * j4 < i; ++j4) {
            const f32x4 av = *(const LAS f32x4*)(rowp + 4 * j4);
            acc[0] = acc[0] - X[4 * j4] * av.x;
            if (4 * j4 + 1 < i) acc[1] = acc[1] - X[4 * j4 + 1] * av.y;
            if (4 * j4 + 2 < i) acc[2] = acc[2] - X[4 * j4 + 2] * av.z;
            if (4 * j4 + 3 < i) acc[3] = acc[3] - X[4 * j4 + 3] * av.w;
        }
        X[i] = (acc[0] + acc[1]) + (acc[2] + acc[3]);
    }
}

DI void pa_phase(const Args& a, LAS unsigned char* lds, int G, int tid, int lane, int wave) {
    unsigned char* ws = a.ws;
    const float* conv_qkv_w = a.in[3];
    bf16* ACT = (bf16*)(ws + WS_ACT); const bf16* HALO = (const bf16*)(ws + WS_HALO); bf16* Wb = (bf16*)(ws + WS_HB);
    const float* Gb = (const float*)(ws + WS_G); const float* Bb = (const float*)(ws + WS_BETA); float* EGL = (float*)(ws + WS_EGL);
    bf16* ATTN = (bf16*)a.out;
    const int sg = wave >> 2, role = (wave & 3) ^ (sg << 1), tsg = tid & 255;
    LAS unsigned char* base = lds + sg * PA_ITEM_LDS;
    LAS unsigned char* KnB = base + PA_KN; LAS unsigned char* QnB = base + PA_QN; LAS unsigned char* ATB = base + PA_AT; LAS unsigned char* VhB = base + PA_VH;
    LAS bf16* Kn = (LAS bf16*)KnB; LAS bf16* Qn = (LAS bf16*)QnB; LAS float* AT = (LAS float*)ATB; LAS float* sm = (LAS float*)(base + PA_SM);
#ifdef DBG_NO_ITEMS
    const int nrounds = 0;
#else
    const int nrounds = (NITEM + 2 * G - 1) / (2 * G);
#endif
    for (int round = 0; round < nrounds; ++round) {
        int ln, tsl;
        const int item = (round * G + (int)blockIdx.x) * 2 + sg; const bool valid = item < NITEM;
        const int h = item & 7, c = (item >> 3) & 31, b = item >> 8; const size_t row0 = (size_t)b * T + (size_t)c * CH;
        ln = lane; tsl = tsg; asm volatile("" : "+v"(ln), "+v"(tsl));
        if (valid) {
            const int seg = tsl & 15, rr0 = tsl >> 4;
            const bf16* hb_ = HALO + ((size_t)(b * NCH + c - 1) * 3) * 3072 + h * HD + seg * 8;
            const bf16* gb_ = ACT + row0 * 1024 + h * HD + seg * 8;
#pragma unroll
            for (int tens = 0; tens < 3; ++tens) {
                LAS unsigned char* dreg = (tens == 0 ? QnB : (tens == 1 ? KnB : ATB)) + seg * 16;
                v4u v[5];
#pragma unroll
                for (int k = 0; k < 5; ++k) { const int rr = rr0 + 16 * k; v[k] = (v4u){0u, 0u, 0u, 0u};
                    if (rr < 67) { if (rr >= 3) v[k] = *(const v4u*)(gb_ + (size_t)tens * ACTSZ + (size_t)(rr - 3) * 1024); else if (c > 0) v[k] = *(const v4u*)(hb_ + (size_t)rr * 3072 + tens * 1024); } }
#pragma unroll
                for (int k = 0; k < 5; ++k) { const int rr = rr0 + 16 * k; if (rr < 67) *(LAS v4u*)(dreg + rr * 256) = v[k]; }
            }
        }
        __syncthreads();
        ln = lane; tsl = tsg; asm volatile("" : "+v"(ln), "+v"(tsl));
        if (valid && role < 3) {
            const int ti = (role == 0) ? 2 : (role == 1 ? 1 : 0);
            const LAS unsigned* rp = (const LAS unsigned*)(role == 0 ? ATB : (role == 1 ? KnB : QnB)) + ln;
            const float* cwp = conv_qkv_w + ti * 1024 + h * HD + 2 * ln;
            f32x2 cw[4];
#pragma unroll
            for (int j = 0; j < 4; ++j) { cw[j].x = cwp[j * 3072]; cw[j].y = cwp[j * 3072 + 1]; }
            f32x2 val[64];
            auto unpk = [](unsigned u) { f32x2 r; r.x = bf_lo(u); r.y = bf_hi(u); return r; };
            f32x2 x0 = unpk(rp[0]), x1 = unpk(rp[64]), x2 = unpk(rp[128]);
            const f32x2 one2 = {1.f, 1.f};
#pragma unroll
            for (int i = 0; i < 64; ++i) { const f32x2 x3 = unpk(rp[(i + 3) * 64]);
                const f32x2 s = cw[0] * x0 + cw[1] * x1 + cw[2] * x2 + cw[3] * x3;
                const f32x2 t = s * (-1.4426950408889634f);
                f32x2 e; e.x = __builtin_amdgcn_exp2f(t.x); e.y = __builtin_amdgcn_exp2f(t.y);
                const f32x2 d = e + one2;
                f32x2 rc; rc.x = __builtin_amdgcn_rcpf(d.x); rc.y = __builtin_amdgcn_rcpf(d.y);
                val[i] = s * rc;
                x0 = x1; x1 = x2; x2 = x3; }
            LAS unsigned* dst = (LAS unsigned*)(role == 0 ? VhB : (role == 1 ? KnB : QnB)) + ln;
            if (role != 0) {
                const float sc = (role == 2) ? 0.08838834764831845f : 1.f;
#pragma unroll
                for (int hb = 0; hb < 64; hb += 32) {
                    float ssq[32];
#pragma unroll
                    for (int i = 0; i < 32; ++i) ssq[i] = val[hb + i].x * val[hb + i].x + val[hb + i].y * val[hb + i].y;
#pragma unroll
                    for (int i = 0; i < 32; ++i) ssq[i] += DPP_MOV(ssq[i], 0xB1);
#pragma unroll
                    for (int i = 0; i < 32; ++i) ssq[i] += DPP_MOV(ssq[i], 0x4E);
#pragma unroll
                    for (int i = 0; i < 32; ++i) ssq[i] += DPP_MOV(ssq[i], 0x141);
#pragma unroll
                    for (int i = 0; i < 32; ++i) ssq[i] += DPP_MOV(ssq[i], 0x140);
#pragma unroll
                    for (int i = 0; i < 32; ++i) ssq[i] += DPP_UPD0(ssq[i], 0x142, 0xA);
#pragma unroll
                    for (int i = 0; i < 32; ++i) ssq[i] += DPP_UPD0(ssq[i], 0x143, 0xC);
#pragma unroll
                    for (int i = 0; i < 32; ++i) { const float tot = __int_as_float(__builtin_amdgcn_readlane(__float_as_int(ssq[i]), 63)); const float rs = sc * __builtin_amdgcn_rsqf(tot + EPS);
                        dst[(hb + i) * (KN_STRIDE / 2)] = cvt_pk_bf16(val[hb + i].x * rs, val[hb + i].y * rs); }
                    __builtin_amdgcn_sched_barrier(0);
                }
            } else {
#pragma unroll
                for (int i = 0; i < 64; ++i) dst[i * (KN_STRIDE / 2)] = cvt_pk_bf16(val[i].x, val[i].y);
            }
        } else if (valid) {
#ifdef DBG_CONST_GATES
            float v = -0.05f; const float bi = 0.5f;
#else
            float v = Gb[(row0 + ln) * 8 + h]; const float bi = Bb[(row0 + ln) * 8 + h];
#endif
#pragma unroll
            for (int o = 1; o < 64; o <<= 1) { const float t = __shfl_up(v, o); if (ln >= o) v += t; }
            const float gl = __shfl(v, 63);
            sm[ln] = v; sm[64 + ln] = bi; sm[128 + ln] = __expf(v); sm[192 + ln] = __expf(gl - v);
            if (ln == 63) EGL[item] = __expf(v);
        }
        __syncthreads();
        ln = lane; tsl = tsg; asm volatile("" : "+v"(ln), "+v"(tsl));
        if (valid) {
            const int r = ln & 15, q = ln >> 4, ti_ = role;
            LDSV(LAS float*, smv, sm); LDSV(LAS float*, ATv, AT); LDSV(LAS bf16*, Knv, Kn); LDSV(LAS bf16*, Qnv, Qn);
            bf16x8 ki[4], qi[4];
#pragma unroll
            for (int s = 0; s < 4; ++s) { ki[s] = *(const LAS bf16x8*)(Knv + (16 * ti_ + r) * KN_STRIDE + 32 * s + 8 * q); qi[s] = *(const LAS bf16x8*)(Qnv + (16 * ti_ + r) * KN_STRIDE + 32 * s + 8 * q); }
            bf16* attn_i = ATTN + (size_t)item * 4096 + (16 * ti_ + r) * 64 + 8 * q;
            const float gci2 = smv[16 * ti_ + r], bi2 = smv[64 + 16 * ti_ + r];
#pragma unroll
            for (int tj = 0; tj < 4; ++tj) {
                bf16* ap = attn_i + 32 * (tj >> 1) + 4 * (tj & 1);
                if (tj <= ti_) {
                    f32x4 c1 = {0.f, 0.f, 0.f, 0.f}, c2 = {0.f, 0.f, 0.f, 0.f};
#pragma unroll
                    for (int s = 0; s < 4; ++s) { const bf16x8 kj = *(const LAS bf16x8*)(Knv + (16 * tj + r) * KN_STRIDE + 32 * s + 8 * q); c1 = MFMA16(kj, ki[s], c1); c2 = MFMA16(kj, qi[s], c2); }
                    const int i2 = 16 * ti_ + r; float p[4];
                    f32x4 o;
#pragma unroll
                    for (int e = 0; e < 4; ++e) { const int j2 = 16 * tj + 4 * q + e; o[e] = (j2 < i2) ? bi2 * __expf(gci2 - smv[j2]) * c1[e] : 0.f; }
                    { v2u na; na.x = cvt_pk_bf16(-o[0], -o[1]); na.y = cvt_pk_bf16(-o[2], -o[3]); *(LAS v2u*)((LAS unsigned char*)ATv + i2 * 144 + (16 * tj + 4 * q) * 2) = na; }
                    if (tj == ti_) *(LAS f32x4*)((LAS unsigned char*)ATv + 9216 + ((ti_ * 16 + r) * 16 + 4 * q) * 4) = o;
#pragma unroll
                    for (int e = 0; e < 4; ++e) { const int j2 = 16 * tj + 4 * q + e; p[e] = (j2 <= i2) ? __expf(gci2 - smv[j2]) * c2[e] : 0.f; }
                    v2u w; w.x = cvt_pk_bf16(p[0], p[1]); w.y = cvt_pk_bf16(p[2], p[3]); *(v2u*)ap = w;
                } else { v2u w; w.x = 0u; w.y = 0u; *(v2u*)ap = w; }
            }
        }
        __syncthreads();
        ln = lane; tsl = tsg; asm volatile("" : "+v"(ln), "+v"(tsl));
        if (valid) {
            LDSV(LAS float*, smv, sm); LDSV(LAS unsigned char*, QnBv, QnB); LDSV(LAS bf16*, Knv, Kn);
            for (int pc = tsl; pc < 1024; pc += 256) {
                const int i = pc >> 4, sg8 = pc & 15, s = sg8 >> 2, q = sg8 & 3; const float e = smv[128 + i];
                const v2u lo = *(const LAS v2u*)(QnBv + i * 272 + (32 * s + 4 * q) * 2), hi = *(const LAS v2u*)(QnBv + i * 272 + (32 * s + 16 + 4 * q) * 2);
                v4u o; o.x = cvt_pk_bf16(bf_lo(lo.x) * e, bf_hi(lo.x) * e); o.y = cvt_pk_bf16(bf_lo(lo.y) * e, bf_hi(lo.y) * e); o.z = cvt_pk_bf16(bf_lo(hi.x) * e, bf_hi(hi.x) * e); o.w = cvt_pk_bf16(bf_lo(hi.y) * e, bf_hi(hi.y) * e);
                *(v4u*)(ACT + (row0 + i) * 1024 + h * HD + sg8 * 8) = o; }
            for (int pc = tsl; pc < 1024; pc += 256) {
                const int dk = pc >> 3, g = pc & 7, s = g >> 2, q = g & 3; float f[8];
#pragma unroll
                for (int e = 0; e < 8; ++e) { const int j = 32 * s + 16 * (e >> 2) + 4 * q + (e & 3); f[e] = __uint_as_float((unsigned)Knv[j * KN_STRIDE + dk] << 16) * smv[192 + j]; }
                v4u o; o.x = cvt_pk_bf16(f[0], f[1]); o.y = cvt_pk_bf16(f[2], f[3]); o.z = cvt_pk_bf16(f[4], f[5]); o.w = cvt_pk_bf16(f[6], f[7]);
                *(v4u*)(ACT + ACTSZ + (row0 + (dk >> 1)) * 1024 + h * HD + (dk & 1) * 64 + g * 8) = o; }
        }
        __syncthreads();
        ln = lane; tsl = tsg; asm volatile("" : "+v"(ln), "+v"(tsl));
        f32x4 Rv[4][4];
        const int cbase = 64 * (role & 1);
        if (valid) {
            LDSV(LAS float*, smv, sm);
            const int r = ln & 15, q = ln >> 4;
            const LAS bf16* tile = (const LAS bf16*)(role < 2 ? VhB : KnB);
#pragma unroll
            for (int bb = 0; bb < 4; ++bb)
#pragma unroll
                for (int e = 0; e < 4; ++e) { const int row = 16 * bb + 4 * q + e; const float be = smv[64 + row], eg = smv[128 + row]; const float f = (role < 2) ? be : be * eg;
#pragma unroll
                    for (int nt = 0; nt < 4; ++nt) Rv[nt][bb][e] = __uint_as_float((unsigned)tile[row * KN_STRIDE + cbase + 16 * nt + r] << 16) * f; }
        }
        __syncthreads();
        ln = lane; tsl = tsg; asm volatile("" : "+v"(ln), "+v"(tsl));
        if (valid) {
            LAS unsigned char* XT = (role < 2 ? VhB : KnB);
            {   LAS unsigned char* zp = XT + cbase * 136 + ln * 16;
                const v4u z4 = {0u, 0u, 0u, 0u};
#pragma unroll
                for (int k = 0; k < 8; ++k) *(LAS v4u*)(zp + 1024 * k) = z4;
                if (ln < 32) *(LAS v4u*)(zp + 8192) = z4; }
            if (role == 0) {
                LDSV(LAS unsigned char*, ATu, ATB);
                const int tb = ln >> 4, tc = ln & 15;
                const LAS float* adg = (const LAS float*)(ATu + 9216) + tb * 256;
                float t[16];
#pragma unroll
                for (int i = 0; i < 16; ++i) { float acc = (tc == i) ? 1.f : 0.f;
#pragma unroll
                    for (int j4 = 0; 4 * j4 < i; ++j4) { const f32x4 av = *(const LAS f32x4*)(adg + i * 16 + 4 * j4);
                        acc -= av.x * t[4 * j4]; if (4 * j4 + 1 < i) acc -= av.y * t[4 * j4 + 1]; if (4 * j4 + 2 < i) acc -= av.z * t[4 * j4 + 2]; if (4 * j4 + 3 < i) acc -= av.w * t[4 * j4 + 3]; }
                    t[i] = acc; }
                LAS unsigned char* tp = ATu + 13312 + tb * 1024 + (8 * (tc >> 2) + (tc & 3)) * 2;
#pragma unroll
                for (int i = 0; i < 16; ++i) { const float to = DPP_MOV(t[i], 0xB1);
                    if ((tc & 1) == 0) *(LAS unsigned*)(tp + i * 64) = cvt_pk_bf16(t[i], to);
                    if ((tc & 3) == 0) { v2u z2; z2.x = 0u; z2.y = 0u; *(LAS v2u*)(tp + i * 64 + 8) = z2; } }
            }
        }
        __syncthreads();
        ln = lane; tsl = tsg; asm volatile("" : "+v"(ln), "+v"(tsl));
        if (valid) {
            LDSV(LAS unsigned char*, ATu, ATB);
            LAS unsigned char* XT = (role < 2 ? VhB : KnB);
            const int r = ln & 15, q = ln >> 4;
            LAS unsigned char* xcol = XT + (cbase + r) * 136;
#pragma unroll
            for (int bb = 0; bb < 4; ++bb) {
                const bf16x8 tf = *(const LAS bf16x8*)(ATu + 13312 + ((bb * 16 + r) * 32 + 8 * q) * 2);
                bf16x8 af[2];
#pragma unroll
                for (int ks = 0; ks < 2; ++ks) if (32 * ks < 16 * bb) af[ks] = *(const LAS bf16x8*)(ATu + (16 * bb + r) * 144 + (32 * ks + 8 * q) * 2);
#pragma unroll
                for (int nt = 0; nt < 4; ++nt) {
                    f32x4 acc = Rv[nt][bb];
#pragma unroll
                    for (int ks = 0; ks < 2; ++ks) if (32 * ks < 16 * bb) {
                        const v2u lo = *(const LAS v2u*)(xcol + nt * (16 * 136) + (32 * ks + 8 * q) * 2), hi = *(const LAS v2u*)(xcol + nt * (16 * 136) + (32 * ks + 8 * q) * 2 + 8);
                        v4u bw; bw.x = lo.x; bw.y = lo.y; bw.z = hi.x; bw.w = hi.y;
                        acc = MFMA16(af[ks], __builtin_bit_cast(bf16x8, bw), acc); }
                    v4u rw; rw.x = cvt_pk_bf16_v(acc[0], acc[1]); rw.y = cvt_pk_bf16_v(acc[2], acc[3]); rw.z = 0u; rw.w = 0u;
                    const f32x4 zero4 = {0.f, 0.f, 0.f, 0.f};
                    const f32x4 x = MFMA16(tf, __builtin_bit_cast(bf16x8, rw), zero4);
                    v2u xw; xw.x = cvt_pk_bf16_v(x[0], x[1]); xw.y = cvt_pk_bf16_v(x[2], x[3]);
                    *(LAS v2u*)(xcol + nt * (16 * 136) + (16 * bb + 4 * q) * 2) = xw;
                }
            }
        }
        __syncthreads();
        ln = lane; tsl = tsg; asm volatile("" : "+v"(ln), "+v"(tsl));
        if (valid) {
            for (int pc = tsl; pc < 2048; pc += 256) { const int which = pc >> 10, id = pc & 1023, i = id & 63, seg = id >> 6;
                const LAS bf16* xt = (const LAS bf16*)(which ? KnB : VhB) + i;
                unsigned short v[8];
#pragma unroll
                for (int e = 0; e < 8; ++e) { const int p = seg * 8 + e; const int col = which ? ((p & ~31) | (((p >> 2) & 1) << 4) | (((p >> 3) & 3) << 2) | (p & 3)) : p; v[e] = xt[col * 68]; }
                v4u o; o.x = (unsigned)v[0] | ((unsigned)v[1] << 16); o.y = (unsigned)v[2] | ((unsigned)v[3] << 16); o.z = (unsigned)v[4] | ((unsigned)v[5] << 16); o.w = (unsigned)v[6] | ((unsigned)v[7] << 16);
                bf16* dstp = which ? (Wb + (row0 + i) * 1024 + h * HD + seg * 8) : (ACT + 2 * ACTSZ + (row0 + i) * 1024 + h * HD + seg * 8);
                *(v4u*)dstp = o; }
        }
        __syncthreads();
    }
}

DI void yc_phase(const Args& a, int first, int G, int tid) {
    unsigned char* ws = a.ws; bf16* ACT = (bf16*)(ws + WS_ACT);
    {
        const float* conv_w = a.in[7]; const float* conv_b = a.in[8];
        const bf16* Pb = ACT + 4 * ACTSZ; bf16* Sb = ACT + 5 * ACTSZ;
        const int cgp = tid & 127, rq = tid >> 7, col = cgp * 8;
        float w0[8], w1[8], w2[8], bb[8];
#pragma unroll
        for (int e = 0; e < 8; ++e) { w0[e] = conv_w[col + e]; w1[e] = conv_w[1024 + col + e]; w2[e] = conv_w[2048 + col + e]; bb[e] = conv_b[col + e]; }
        for (int rc = (int)blockIdx.x - first; rc < M / 64; rc += G - first) {
            const size_t r0 = (size_t)rc * 64 + rq * 16;
            v4u pm2 = {0u, 0u, 0u, 0u}, pm1 = {0u, 0u, 0u, 0u};
            if ((r0 & (T - 1)) != 0) { pm2 = *(const v4u*)(Pb + (r0 - 2) * 1024 + col); pm1 = *(const v4u*)(Pb + (r0 - 1) * 1024 + col); }
#pragma unroll 4
            for (int i = 0; i < 16; ++i) {
                const v4u p0 = *(const v4u*)(Pb + (r0 + i) * 1024 + col); const v4u sv = *(const v4u*)(Sb + (r0 + i) * 1024 + col);
                v4u o;
#pragma unroll
                for (int e = 0; e < 4; ++e) {
                    const float ylo = bf_lo(sv[e]) * (w0[2 * e] * bf_lo(pm2[e]) + w1[2 * e] * bf_lo(pm1[e]) + w2[2 * e] * bf_lo(p0[e]) + bb[2 * e]);
                    const float yhi = bf_hi(sv[e]) * (w0[2 * e + 1] * bf_hi(pm2[e]) + w1[2 * e + 1] * bf_hi(pm1[e]) + w2[2 * e + 1] * bf_hi(p0[e]) + bb[2 * e + 1]);
                    o[e] = cvt_pk_bf16(ylo, yhi); }
                *(v4u*)(Sb + (r0 + i) * 1024 + col) = o;
                pm2 = pm1; pm1 = p0;
            }
        }
    }
}

constexpr int PB_W = 0, PB_Q = 64 * 272, PB_K = 2 * 64 * 272, PB_A = 3 * 64 * 272, PB_U = PB_A + 64 * 144, PB_BUF = PB_U + 64 * 144;
static_assert(2 * PB_BUF <= LDS_BYTES - 16, "PB LDS");
DI void pb_phase(const Args& a, LAS unsigned char* lds, int vcu, int G, int tid, int lane, int wave) {
    unsigned char* ws = a.ws;
    bf16* ACT = (bf16*)(ws + WS_ACT); const bf16* Wb = (const bf16*)(ws + WS_HB); const float* EGL = (const float*)(ws + WS_EGL);
    const bf16* ATTN = (const bf16*)a.out;
    const int r = lane & 15, q = lane >> 4;
    for (int unit = blockIdx.x; unit < 2 * BATCH * NH; unit += G) {
        const int half = (unit >> 3) & 1, bh = (unit & 7) + 8 * (unit >> 4), h = bh & 7, b = bh >> 3;
        if (wave >= 4) {
            const int tl = tid - 256;
            v4u st[16];
#define PB_ISSUE(c_) do { const size_t row0_ = (size_t)b * T + (size_t)(c_) * CH; const int item_ = (b * NCH + (c_)) * NH + h; \
                _Pragma("unroll") for (int k = 0; k < 12; ++k) { const int p = tl + 256 * (k & 3), rw = p >> 4, sg_ = p & 15; \
                    const bf16* src = (k < 4 ? Wb : (k < 8 ? (const bf16*)ACT : (const bf16*)(ACT + ACTSZ))) + (row0_ + rw) * 1024 + h * HD + sg_ * 8; st[k] = *(const v4u*)src; } \
                _Pragma("unroll") for (int k = 12; k < 14; ++k) { const int p = tl + 256 * (k - 12); st[k] = *(const v4u*)(ATTN + (size_t)item_ * 4096 + (p >> 3) * 64 + (p & 7) * 8); } \
                _Pragma("unroll") for (int k = 14; k < 16; ++k) { const int p = tl + 256 * (k - 14); st[k] = *(const v4u*)(ACT + 2 * ACTSZ + (row0_ + (p >> 3)) * 1024 + h * HD + 64 * half + (p & 7) * 8); } } while (0)
#define PB_COMMIT(buf_) do { LAS unsigned char* bb_ = lds + (buf_) * PB_BUF; \
                _Pragma("unroll") for (int k = 0; k < 12; ++k) { const int p = tl + 256 * (k & 3), rw = p >> 4, sg_ = p & 15; *(LAS v4u*)(bb_ + (k >> 2) * (64 * 272) + rw * 272 + sg_ * 16) = st[k]; } \
                _Pragma("unroll") for (int k = 12; k < 14; ++k) { const int p = tl + 256 * (k - 12); *(LAS v4u*)(bb_ + PB_A + (p >> 3) * 144 + (p & 7) * 16) = st[k]; } \
                _Pragma("unroll") for (int k = 14; k < 16; ++k) { const int p = tl + 256 * (k - 14); *(LAS v4u*)(bb_ + PB_U + (p >> 3) * 144 + (p & 7) * 16) = st[k]; } } while (0)
            PB_ISSUE(0); PB_COMMIT(0); PB_ISSUE(1);
            __syncthreads();
            for (int c = 0; c < NCH; ++c) {
                if (c + 1 < NCH) PB_COMMIT((c + 1) & 1);
                if (c + 2 < NCH) PB_ISSUE(c + 2);
                __syncthreads();
            }
#undef PB_ISSUE
#undef PB_COMMIT
        } else {
            const int sl = 4 * half + wave;
            f32x4 S[8];
#pragma unroll
            for (int tm = 0; tm < 8; ++tm) S[tm] = (f32x4){0.f, 0.f, 0.f, 0.f};
            __syncthreads();
            for (int c = 0; c < NCH; ++c) {
                const size_t row0 = (size_t)b * T + (size_t)c * CH; const int item = (b * NCH + c) * NH + h;
                const LAS unsigned char* bb = lds + (c & 1) * PB_BUF;
                const LAS unsigned char* wp = bb + PB_W + r * 272 + q * 16;
                const LAS unsigned char* qp = bb + PB_Q + r * 272 + q * 16;
                const LAS unsigned char* kp = bb + PB_K + (r >> 1) * 272 + (r & 1) * 128 + q * 16;
                const LAS unsigned char* ap = bb + PB_A + r * 144 + q * 16;
                const LAS bf16* uq = (const LAS bf16*)(bb + PB_U + (4 * q) * 144) + 16 * wave + r;
                const float egl = EGL[item];
                bf16x8 Sb[4];
#pragma unroll
                for (int s = 0; s < 4; ++s) { v4u w; w.x = cvt_pk_bf16_v(S[2 * s][0], S[2 * s][1]); w.y = cvt_pk_bf16_v(S[2 * s][2], S[2 * s][3]); w.z = cvt_pk_bf16_v(S[2 * s + 1][0], S[2 * s + 1][1]); w.w = cvt_pk_bf16_v(S[2 * s + 1][2], S[2 * s + 1][3]);
                    Sb[s] = __builtin_bit_cast(bf16x8, w); }
                f32x4 vn[4], O[4];
#pragma unroll
                for (int t = 0; t < 4; ++t) {
                    f32x4 p = {0.f, 0.f, 0.f, 0.f}, o = {0.f, 0.f, 0.f, 0.f};
#pragma unroll
                    for (int s = 0; s < 4; ++s) { const bf16x8 wf = *(const LAS bf16x8*)(wp + t * (16 * 272) + s * 64); const bf16x8 qf = *(const LAS bf16x8*)(qp + t * (16 * 272) + s * 64);
                        p = MFMA16(wf, Sb[s], p); o = MFMA16(qf, Sb[s], o); }
#pragma unroll
                    for (int e = 0; e < 4; ++e) vn[t][e] = __uint_as_float((unsigned)uq[(16 * t + e) * 72] << 16) - p[e];
                    O[t] = o;
                }
                bf16x8 vb[2];
#pragma unroll
                for (int s = 0; s < 2; ++s) { v4u w; w.x = cvt_pk_bf16_v(vn[2 * s][0], vn[2 * s][1]); w.y = cvt_pk_bf16_v(vn[2 * s][2], vn[2 * s][3]); w.z = cvt_pk_bf16_v(vn[2 * s + 1][0], vn[2 * s + 1][1]); w.w = cvt_pk_bf16_v(vn[2 * s + 1][2], vn[2 * s + 1][3]);
                    vb[s] = __builtin_bit_cast(bf16x8, w); }
#pragma unroll
                for (int t = 0; t < 4; ++t) {
#pragma unroll
                    for (int s = 0; s < 2; ++s) { const bf16x8 af = *(const LAS bf16x8*)(ap + t * (16 * 144) + s * 64); O[t] = MFMA16(af, vb[s], O[t]); }
                }
#pragma unroll
                for (int tm = 0; tm < 8; ++tm) {
                    f32x4 acc = S[tm] * egl;
#pragma unroll
                    for (int s = 0; s < 2; ++s) { const bf16x8 kf = *(const LAS bf16x8*)(kp + tm * (8 * 272) + s * 64); acc = MFMA16(kf, vb[s], acc); }
                    S[tm] = acc;
                }
                bf16* up = ACT + 2 * ACTSZ + (row0 + 4 * q) * 1024 + h * HD + 16 * sl + r;
#pragma unroll
                for (int t = 0; t < 4; ++t)
#pragma unroll
                    for (int e = 0; e < 4; ++e) up[(size_t)(16 * t + e) * 1024] = (bf16)(cvt_pk_bf16_v(O[t][e], 0.f) & 0xffffu);
                __syncthreads();
            }
        }
    }
}

DI void pg_phase(const Args& a, int G, int tid) {
    unsigned char* ws = a.ws; const float* gw = a.in[6];
    bf16* ACT = (bf16*)(ws + WS_ACT); bf16* Ob = ACT + 2 * ACTSZ; const bf16* Zb = ACT + 3 * ACTSZ;
    const size_t total = (size_t)M * 128, stride = (size_t)G * 512;
    const int dv0 = (tid & 15) * 8;
    const f32x4 g0 = *(const f32x4*)(gw + dv0), g1 = *(const f32x4*)(gw + dv0 + 4);
    const float gg[8] = {g0.x, g0.y, g0.z, g0.w, g1.x, g1.y, g1.z, g1.w};
    for (size_t base = (size_t)blockIdx.x * 512 + tid; base < total; base += 8 * stride) {
        v4u ov[8], zv[8];
#pragma unroll
        for (int u = 0; u < 8; ++u) { const size_t idx = base + u * stride; if (idx < total) { const size_t m = idx >> 7; const int cgp = (int)(idx & 127);
            ov[u] = *(const v4u*)(Ob + m * 1024 + cgp * 8); zv[u] = *(const v4u*)(Zb + m * 1024 + cgp * 8); } }
#pragma unroll
        for (int u = 0; u < 8; ++u) { const size_t idx = base + u * stride; if (idx < total) { const size_t m = idx >> 7; const int cgp = (int)(idx & 127);
            float of[8], ss = 0.f;
#pragma unroll
            for (int e = 0; e < 4; ++e) { of[2 * e] = bf_lo(ov[u][e]); of[2 * e + 1] = bf_hi(ov[u][e]); ss += of[2 * e] * of[2 * e] + of[2 * e + 1] * of[2 * e + 1]; }
            ss = row16_sum(ss);
            const float rstd = __builtin_amdgcn_rsqf(ss * (1.f / HD) + EPS);
            v4u o;
#pragma unroll
            for (int e = 0; e < 4; ++e) o[e] = cvt_pk_bf16(of[2 * e] * rstd * gg[2 * e] * bf_lo(zv[u][e]), of[2 * e + 1] * rstd * gg[2 * e + 1] * bf_hi(zv[u][e]));
            *(v4u*)(Ob + m * 1024 + cgp * 8) = o; } }
    }
}

DI void p6_phase(const Args& a, int vcu, int G, int lane, int wave) {
    const float* fw = a.in[10];
    const int gw = vcu * NWAVES + wave, NGW = G * NWAVES;
    f32x4 w[4];
#pragma unroll
    for (int j = 0; j < 4; ++j) w[j] = ((const f32x4*)fw)[lane + 64 * j];
    for (int m = gw; m < M; m += 4 * NGW) {
        f32x4 v[4][4];
#pragma unroll
        for (int u = 0; u < 4; ++u) { const int mm = m + u * NGW; if (mm < M) { const f32x4* yr = (const f32x4*)(a.out + (size_t)mm * D) + lane;
#pragma unroll
            for (int j = 0; j < 4; ++j) v[u][j] = yr[64 * j]; } }
#pragma unroll
        for (int u = 0; u < 4; ++u) { const int mm = m + u * NGW; if (mm < M) { f32x4* yr = (f32x4*)(a.out + (size_t)mm * D) + lane; float s = 0.f;
#pragma unroll
            for (int j = 0; j < 4; ++j) s += (v[u][j].x * v[u][j].x + v[u][j].y * v[u][j].y) + (v[u][j].z * v[u][j].z + v[u][j].w * v[u][j].w);
            const float rstd = 1.f / sqrtf(wave_sum(s) * (1.f / D) + EPS);
#pragma unroll
            for (int j = 0; j < 4; ++j) yr[64 * j] = v[u][j] * rstd * w[j]; } }
    }
}

#ifndef MK_SKIP_GDN
#define MK_SKIP_GDN 0
#endif
__global__ void __launch_bounds__(NWAVES * 64, 2) hybrid_fwd(Args args) {
    extern __shared__ __attribute__((aligned(16))) unsigned char lds_raw[];
    cg::grid_group grid = cg::this_grid();
    LAS unsigned char* lds = (LAS unsigned char*)lds_raw;
    const int tid = threadIdx.x, lane = tid & 63, wave = __builtin_amdgcn_readfirstlane(tid >> 6);
    const int G = gridDim.x, bx = blockIdx.x;
    const int vcu = (G % 8 == 0) ? (bx % 8) * (G / 8) + bx / 8 : bx;
    unsigned char* ws = args.ws;
    bf16* ACT = (bf16*)(ws + WS_ACT);

    volatile LAS unsigned* xst = (volatile LAS unsigned*)(lds + LDS_BYTES - 16);
    if (tid < 4) xst[tid] = 0u;
    __syncthreads();
    XcdBarrier xbar = xcd_barrier_post((unsigned*)ws, xst);
#ifndef NO_P0
    p0_prologue(args, lds, vcu, G, tid, lane, wave);
#endif
    if (bx == 0 && tid < 64) ((unsigned*)(ws + WS_EGL + 32768))[16 * tid] = 0u;
#ifdef PROBE_P0X2
    __syncthreads();
    p0_prologue(args, lds, vcu, G, tid, lane, wave);
#endif
    grid.sync();
    {
        pg8::Gemm g{(const bf16*)(ws + WS_HB), (const bf16*)(ws + WS_WIN), M, N1, D, D, D / 64, 0};
        pg8::StaticOrder S; S.init(M, N1, G, bx);
        pg8::EpiProj E{ACT, (bf16*)(ws + WS_HALO), ACTSZ};
        pg8::gemm_phase<pg8::EpiProj, pg8::StaticOrder, true, true>(lds, g, S, E);
#ifdef PROBE_P1X2
        pg8::gemm_phase<pg8::EpiProj, pg8::StaticOrder, true, true>(lds, g, S, E);
#endif
    }
    xcd_barrier(xbar);
#ifndef NO_PA
    pa_phase(args, lds, G, tid, lane, wave);
#endif
    xcd_barrier(xbar);
#ifndef NO_PB
    pb_phase(args, lds, vcu, G, tid, lane, wave);
#endif
    if (G > 2 * BATCH * NH) { if (bx >= 2 * BATCH * NH) yc_phase(args, 2 * BATCH * NH, G, tid); } else yc_phase(args, 0, G, tid);
    xcd_barrier(xbar);
    pg_phase(args, G, tid);
    xcd_barrier(xbar);
    {
        pg8::Gemm g{ACT + 2 * ACTSZ, (const bf16*)(ws + WS_WOUT), M, D, KMIX, 1024, 16, (long)(3 * ACTSZ * 2)};
        pg8::StaticOrder S; S.init(M, D, G, bx);
        if (G == 256) {
            pg8::EpiResNorm E{args.in[0], args.out, args.in[10], (float*)(ws + WS_SSQ), (unsigned*)(ws + WS_EGL + 32768), D, EPS};
            pg8::gemm_phase<pg8::EpiResNorm, pg8::StaticOrder, false, true>(lds, g, S, E);
        } else {
            pg8::EpiRes E{args.in[0], args.out, D};
            pg8::gemm_phase<pg8::EpiRes, pg8::StaticOrder, true, true>(lds, g, S, E);
            grid.sync();
            p6_phase(args, vcu, G, lane, wave);
        }
    }
}

extern "C" void kernel_launch(void* const* d_in, const int* in_sizes, int n_in, void* d_out, int out_size, void* d_ws, size_t ws_size, hipStream_t stream) {
    static int grid = 0;
    if (grid == 0) {
        if (n_in != 11 || in_sizes[0] != M * D || out_size != M * D || ws_size < WS_END) { fprintf(stderr, "kernel_launch: unexpected shapes (n_in %d, in0 %d, out %d, ws %zu)\n", n_in, n_in > 0 ? in_sizes[0] : -1, out_size, ws_size); grid = -1; return; }
        int dev = 0, cus = 0, per_cu = 0;
        if (hipGetDevice(&dev) != hipSuccess || hipDeviceGetAttribute(&cus, hipDeviceAttributeMultiprocessorCount, dev) != hipSuccess) { grid = -1; return; }
        if (hipFuncSetAttribute((const void*)hybrid_fwd, hipFuncAttributeMaxDynamicSharedMemorySize, LDS_BYTES) != hipSuccess) { fprintf(stderr, "kernel_launch: hipFuncSetAttribute failed\n"); grid = -1; return; }
        if (hipOccupancyMaxActiveBlocksPerMultiprocessor(&per_cu, (const void*)hybrid_fwd, NWAVES * 64, LDS_BYTES) != hipSuccess || per_cu < 1) { fprintf(stderr, "kernel_launch: occupancy query gave %d\n", per_cu); (void)hipGetLastError(); per_cu = 1; }
        grid = cus * 1;
        if (grid > cus * per_cu) grid = cus * per_cu;
    }
    if (grid < 0) return;
    if (hipMemsetAsync(d_ws, 0, 16384, stream) != hipSuccess) { fprintf(stderr, "kernel_launch: memset of the barrier words failed\n"); return; }
    Args a{};
    for (int i = 0; i < 11; ++i) a.in[i] = (const float*)d_in[i];
    a.out = (float*)d_out; a.ws = (unsigned char*)d_ws;
    void* kargs[] = {&a};
    hipError_t e = hipLaunchCooperativeKernel((const void*)hybrid_fwd, dim3(grid), dim3(NWAVES * 64), kargs, LDS_BYTES, stream);
    if (e != hipSuccess) fprintf(stderr, "kernel_launch: cooperative launch failed: %s (grid %d)\n", hipGetErrorString(e), grid);
}
```

```cpp
#include <hip/hip_runtime.h>
#include <hip/hip_cooperative_groups.h>
#include <cstdio>
#include <cstdint>
namespace cg = cooperative_groups;
namespace pg8 {
#define PG8_LAS __attribute__((address_space(3)))
typedef unsigned short bf16_t;
typedef short bf16x8 __attribute__((ext_vector_type(8)));
typedef float f32x4 __attribute__((ext_vector_type(4)));
typedef unsigned u32x4 __attribute__((ext_vector_type(4)));
constexpr int BM = 256, BK = 64, HALF = 128, HTB = HALF * BK * 2  , STAGE_BYTES = 8 * HTB, NXCD = 8, WGM = 8;

__host__ __device__ __forceinline__ int lds_byte(int r, int c) { const int st = (r >> 4) * 2 + (c >> 5), rr = r & 15, cc = c & 31, ob = rr * 64 + cc * 2; return st * 1024 + (ob ^ (((ob >> 9) & 1) << 5)); }
__host__ __device__ __forceinline__ void stage_rc(int b, int& R, int& C) { const int st = b / 1024, sb = b % 1024, swz = sb ^ (((sb >> 9) & 1) << 5); R = (st >> 1) * 16 + swz / 64; C = (st & 1) * 32 + (swz % 64) / 2; }
__host__ __device__ __forceinline__ int perm32(int rho) { const int n = rho >> 4, i = rho & 15; return 8 * (i >> 2) + 4 * n + (i & 3); }

struct Unit { int pm, pn; };
struct Gemm { const bf16_t* A; const bf16_t* Bt; int M, N, K, lda, ksplit; long a2off; };

struct StaticOrder {
    int nM, nN, nwg, G, c;
    __host__ __device__ void init(int M, int N, int G_, int c_) { nM = M / BM; nN = N / BM; nwg = nM * nN; G = G_; c = c_; }
    __host__ __device__ bool next(int i, Unit& u) const {
        const long L = (long)i * G + c; if (L >= nwg) return false;
        int wgid = (int)L; { const int q = nwg / NXCD, r = nwg % NXCD, xcd = wgid % NXCD, off = wgid / NXCD; wgid = (xcd < r ? xcd * (q + 1) : r * (q + 1) + (xcd - r) * q) + off; }
        const int nig = WGM * nN, gid = wgid / nig, fm = gid * WGM, gsz = (nM - fm) < WGM ? (nM - fm) : WGM;
        u.pm = fm + ((wgid % nig) % gsz); u.pn = (wgid % nig) / gsz; return true;
    }
    __device__ __forceinline__ void a_ready(const Unit&) const {}
    __device__ __forceinline__ void done(const Unit&) const {}
};


typedef float f32x2_cv __attribute__((ext_vector_type(2)));
typedef __bf16 bf16x2_cv __attribute__((ext_vector_type(2)));
__device__ __forceinline__ unsigned cvt_pk_bf16_v(float lo, float hi) { f32x2_cv v = {lo, hi}; bf16x2_cv r = __builtin_convertvector(v, bf16x2_cv); return __builtin_bit_cast(unsigned, r); }
__device__ __forceinline__ unsigned cvt_pk_bf16(float lo, float hi) { unsigned r; asm volatile("v_cvt_pk_bf16_f32 %0, %1, %2" : "=v"(r) : "v"(lo), "v"(hi)); return r; }
__device__ __forceinline__ float silu_f(float x) { return x * __builtin_amdgcn_rcpf(1.f + __expf(-x)); }

struct EpiProj {
    static constexpr bool PERM = true, AFTER_DRAIN = false;
    bf16_t* ACT; bf16_t* HALO; size_t actsz;
    __device__ __forceinline__ void operator()(const f32x4 (&acc)[2][2][4][2], const Unit& u, int wr, int wc, int fr, int fq) const {
        const int pn = u.pn, row0 = u.pm * BM + wr * 64 + fr, cw = wc * 32 + 8 * fq;
        if (pn < 16) {
            bf16_t* base = ACT + (size_t)(pn >> 2) * actsz + (pn & 3) * 256 + cw;
            const bool act = pn >= 12, halo = pn < 12;
#pragma unroll
            for (int ai = 0; ai < 2; ++ai)
#pragma unroll
                for (int m = 0; m < 4; ++m) { const int row = row0 + ai * HALF + m * 16; bf16_t* rowp = base + (size_t)row * 1024;
#pragma unroll
                    for (int bj = 0; bj < 2; ++bj) { f32x4 v0 = acc[ai][bj][m][0], v1 = acc[ai][bj][m][1];
                        if (act) {
#pragma unroll
                            for (int j = 0; j < 4; ++j) { v0[j] = silu_f(v0[j]); v1[j] = silu_f(v1[j]); } }
                        u32x4 w; w.x = cvt_pk_bf16_v(v0[0], v0[1]); w.y = cvt_pk_bf16_v(v0[2], v0[3]); w.z = cvt_pk_bf16_v(v1[0], v1[1]); w.w = cvt_pk_bf16_v(v1[2], v1[3]);
                        *(u32x4*)(rowp + bj * HALF) = w;
                        if (m == 3 && halo && fr >= 13) *(u32x4*)(HALO + ((size_t)(row >> 6) * 3 + (fr - 13)) * 3072 + pn * 256 + bj * HALF + cw) = w; } }
        } else {
            const bool kind = pn >= 24; bf16_t* base = ACT + (size_t)(kind ? 5 : 4) * actsz + ((pn - 16) & 7) * 128 + cw;
#pragma unroll
            for (int ai = 0; ai < 2; ++ai)
#pragma unroll
                for (int m = 0; m < 4; ++m) { const int row = row0 + ai * HALF + m * 16;
                    f32x4 a0 = acc[ai][0][m][0], a1 = acc[ai][0][m][1], b0 = acc[ai][1][m][0], b1 = acc[ai][1][m][1];
                    if (kind) {
#pragma unroll
                        for (int j = 0; j < 4; ++j) { b0[j] = silu_f(b0[j]); b1[j] = silu_f(b1[j]); } }
                    a0 = a0 * b0; a1 = a1 * b1;
                    u32x4 w; w.x = cvt_pk_bf16(a0[0], a0[1]); w.y = cvt_pk_bf16(a0[2], a0[3]); w.z = cvt_pk_bf16(a1[0], a1[1]); w.w = cvt_pk_bf16(a1[2], a1[3]);
                    *(u32x4*)(base + (size_t)row * 1024) = w; }
        }
    }
};
struct EpiResNorm {
    static constexpr bool PERM = false, AFTER_DRAIN = true;
    const float* X; float* Y; const float* FW; float* part; unsigned* cnt; int ldc; float eps;
    __device__ __forceinline__ void operator()(const f32x4 (&)[2][2][4][2], const Unit&, int, int, int, int) const {}
    __device__ __forceinline__ void fused(const f32x4 (&acc)[2][2][4][2], const Unit& u, int wr, int wc, int fr, int fq, PG8_LAS unsigned char* lds, int wid, int lane) const {
        PG8_LAS float* red = (PG8_LAS float*)lds;
        PG8_LAS float* rs = (PG8_LAS float*)(lds + 4096);
        const int row0 = u.pm * BM + wr * 64 + fr, col0 = u.pn * BM + wc * 32 + 4 * fq; int tid = threadIdx.x; asm volatile("" : "+v"(tid));
#pragma unroll
        for (int ai = 0; ai < 2; ++ai)
#pragma unroll
            for (int m = 0; m < 4; ++m) { const size_t o = (size_t)(row0 + ai * HALF + m * 16) * ldc + col0; float ss = 0.f;
#pragma unroll
                for (int bj = 0; bj < 2; ++bj)
#pragma unroll
                    for (int n = 0; n < 2; ++n) { const f32x4 y = acc[ai][bj][m][n] + *(const f32x4*)(X + o + bj * HALF + n * 16); ss += (y.x * y.x + y.y * y.y) + (y.z * y.z + y.w * y.w); }
                ss += __shfl_xor(ss, 16); ss += __shfl_xor(ss, 32);
                if (fq == 0) red[((wr * 4 + wc) * 8 + ai * 4 + m) * 16 + fr] = ss; }
        __syncthreads();
        if (tid < 256) { const int w_ = (tid >> 6) & 1, ai = tid >> 7, m = (tid >> 4) & 3, f = tid & 15; float s = 0.f;
#pragma unroll
            for (int c = 0; c < 4; ++c) s += red[((w_ * 4 + c) * 8 + ai * 4 + m) * 16 + f];
            __hip_atomic_store(part + (size_t)(u.pm * BM + tid) * 4 + u.pn, s, __ATOMIC_RELAXED, __HIP_MEMORY_SCOPE_AGENT); }
        asm volatile("s_waitcnt vmcnt(0)" ::: "memory");
        __syncthreads();
        if (tid == 0) { __hip_atomic_fetch_add(cnt + 16 * u.pm, 1u, __ATOMIC_RELAXED, __HIP_MEMORY_SCOPE_AGENT);
            while (__hip_atomic_load(cnt + 16 * u.pm, __ATOMIC_RELAXED, __HIP_MEMORY_SCOPE_AGENT) < 4u) __builtin_amdgcn_s_sleep(2); }
        __syncthreads();
        if (tid < 256) { const float* pp = part + (size_t)(u.pm * BM + tid) * 4; float s = 0.f;
#pragma unroll
            for (int c = 0; c < 4; ++c) s += __hip_atomic_load(pp + c, __ATOMIC_RELAXED, __HIP_MEMORY_SCOPE_AGENT);
            rs[tid] = 1.f / sqrtf(s * (1.f / 1024.f) + eps); }
        __syncthreads();
        f32x4 fw[2][2];
#pragma unroll
        for (int bj = 0; bj < 2; ++bj)
#pragma unroll
            for (int n = 0; n < 2; ++n) fw[bj][n] = *(const f32x4*)(FW + col0 + bj * HALF + n * 16);
#pragma unroll
        for (int ai = 0; ai < 2; ++ai)
#pragma unroll
            for (int m = 0; m < 4; ++m) { const size_t o = (size_t)(row0 + ai * HALF + m * 16) * ldc + col0; const float rstd = rs[ai * HALF + wr * 64 + m * 16 + fr];
#pragma unroll
                for (int bj = 0; bj < 2; ++bj)
#pragma unroll
                    for (int n = 0; n < 2; ++n) { const f32x4 y = acc[ai][bj][m][n] + *(const f32x4*)(X + o + bj * HALF + n * 16); *(f32x4*)(Y + o + bj * HALF + n * 16) = y * rstd * fw[bj][n]; } }
    }
};
struct EpiRes {
    static constexpr bool PERM = false, AFTER_DRAIN = false;
    const float* X; float* Y; int ldc;
    __device__ __forceinline__ void operator()(const f32x4 (&acc)[2][2][4][2], const Unit& u, int wr, int wc, int fr, int fq) const {
        const int row0 = u.pm * BM + wr * 64 + fr, col0 = u.pn * BM + wc * 32 + 4 * fq;
#pragma unroll
        for (int ai = 0; ai < 2; ++ai)
#pragma unroll
            for (int m = 0; m < 4; ++m) { const size_t o = (size_t)(row0 + ai * HALF + m * 16) * ldc + col0;
#pragma unroll
                for (int bj = 0; bj < 2; ++bj)
#pragma unroll
                    for (int n = 0; n < 2; ++n) *(f32x4*)(Y + o + bj * HALF + n * 16) = acc[ai][bj][m][n] + *(const f32x4*)(X + o + bj * HALF + n * 16); }
    }
};

template <class Epi, class Sched, bool ALIGN_EPI = false, bool SP2 = false>
__device__ __forceinline__ void gemm_phase(PG8_LAS unsigned char* lds, const Gemm g, const Sched& S, const Epi& E) {
    const int tid = threadIdx.x, wid = __builtin_amdgcn_readfirstlane(tid >> 6), lane = tid & 63, wr = wid >> 2, wc = wid & 3, fr = lane & 15, fq = lane >> 4;
    const int K = g.K, nt = K / BK, lda = g.lda, ksplit = g.ksplit; const long a2off = g.a2off;
    unsigned voffA[2], voffB[2];
#pragma unroll
    for (int i = 0; i < 2; ++i) { int R, C; stage_rc(tid * 16 + i * 8192, R, C); const int Rb = Epi::PERM ? ((R & ~31) + perm32(R & 31)) : R;
        voffA[i] = (unsigned)(R * lda + C) * 2u; voffB[i] = (unsigned)(Rb * K + C) * 2u; }
    const size_t kstep = (size_t)(BK * 2);
    const size_t hstep = (size_t)HALF * K * 2;
    const size_t tstep = 2 * hstep; const size_t hstepA = (size_t)HALF * lda * 2, tstepA = 2 * hstepA;
#define PG8_AK(base, t) ((base) + (((t) < ksplit) ? (long)(t) * (long)kstep : a2off + (long)((t) - ksplit) * (long)kstep))
    const unsigned ldsw = (unsigned)wid * 1024u;
    const int aoff = lds_byte(wr * 64 + fr, fq * 8), boff = lds_byte(wc * 32 + fr, fq * 8);
#define PG8_SA(b, h) (((b) * 2 + (h)) * HTB)
#define PG8_SB(b, h) ((4 + (b) * 2 + (h)) * HTB)
#define PG8_STAGE(bufoff, gbase, voff) do { _Pragma("unroll") for (int _i = 0; _i < 2; ++_i) \
        __builtin_amdgcn_global_load_lds((const unsigned*)((const char*)(gbase) + (voff)[_i]), (PG8_LAS unsigned*)(lds + (bufoff) + ldsw + _i * 8192), 16, 0, 0); } while (0)
#define PG8_LDA(dst, b, h) do { _Pragma("unroll") for (int m = 0; m < 4; ++m) _Pragma("unroll") for (int k = 0; k < 2; ++k) dst[m][k] = *(const PG8_LAS bf16x8*)(lds + PG8_SA(b, h) + aoff + m * 2048 + k * 1024); } while (0)
#define PG8_LDB(dst, b, h) do { _Pragma("unroll") for (int n = 0; n < 2; ++n) _Pragma("unroll") for (int k = 0; k < 2; ++k) dst[n][k] = *(const PG8_LAS bf16x8*)(lds + PG8_SB(b, h) + boff + n * 2048 + k * 1024); } while (0)
#define PG8_MMA(ai, bj, At, Bt) do { __builtin_amdgcn_s_setprio(1); _Pragma("unroll") for (int m = 0; m < 4; ++m) _Pragma("unroll") for (int n = 0; n < 2; ++n) _Pragma("unroll") for (int k = 0; k < 2; ++k) \
        acc[ai][bj][m][n] = __builtin_amdgcn_mfma_f32_16x16x32_bf16(Bt[n][k], At[m][k], acc[ai][bj][m][n], 0, 0, 0); __builtin_amdgcn_s_setprio(0); } while (0)
#define PG8_WAIT_V(n) asm volatile("s_waitcnt vmcnt(" #n ")" ::: "memory")
#define PG8_WAIT_L(n) asm volatile("s_waitcnt lgkmcnt(" #n ")" ::: "memory")
#define PG8_BAR __builtin_amdgcn_s_barrier()
#define PG8_SCHED __builtin_amdgcn_sched_barrier(0)
    Unit cur, nxt; int ui = 0;
    if (!S.next(0, cur)) return;
    f32x4 acc[2][2][4][2];
#pragma unroll
    for (int a = 0; a < 2; ++a)
#pragma unroll
        for (int b = 0; b < 2; ++b)
#pragma unroll
            for (int m = 0; m < 4; ++m)
#pragma unroll
                for (int n = 0; n < 2; ++n) acc[a][b][m][n] = (f32x4){0.f, 0.f, 0.f, 0.f};
    bf16x8 At[4][2], B0[2][2], B1[2][2];
    const char* cA = (const char*)g.A + (size_t)cur.pm * tstepA; const char* cB = (const char*)g.Bt + (size_t)cur.pn * tstep;
    S.a_ready(cur);
    if constexpr (SP2) {
        PG8_STAGE(PG8_SB(0, 0), cB, voffB); PG8_STAGE(PG8_SB(0, 1), cB + hstep, voffB); PG8_STAGE(PG8_SA(0, 0), cA, voffA); PG8_STAGE(PG8_SA(0, 1), cA + hstepA, voffA);
        if (wr == 1) PG8_BAR;
        PG8_WAIT_V(2); PG8_BAR;
        PG8_STAGE(PG8_SB(1, 0), cB + kstep, voffB); PG8_STAGE(PG8_SA(1, 0), cA + kstep, voffA); PG8_STAGE(PG8_SB(1, 1), cB + hstep + kstep, voffB);
        PG8_WAIT_V(6); PG8_BAR;
    } else {
        PG8_STAGE(PG8_SB(0, 0), cB, voffB); PG8_STAGE(PG8_SA(0, 0), cA, voffA); PG8_STAGE(PG8_SB(0, 1), cB + hstep, voffB); PG8_STAGE(PG8_SA(0, 1), cA + hstepA, voffA);
        if (wr == 1) PG8_BAR;
        PG8_WAIT_V(4); PG8_BAR;
        PG8_STAGE(PG8_SB(1, 0), cB + kstep, voffB); PG8_STAGE(PG8_SA(1, 0), cA + kstep, voffA); PG8_STAGE(PG8_SB(1, 1), cB + hstep + kstep, voffB);
        PG8_WAIT_V(6); PG8_BAR;
    }
    for (;;) {
        const bool has_next = S.next(ui + 1, nxt);
        const char* nA = has_next ? (const char*)g.A + (size_t)nxt.pm * tstepA : cA; const char* nB = has_next ? (const char*)g.Bt + (size_t)nxt.pn * tstep : cB;
        for (int t = 0; t < nt; t += 2) {
            const bool last = (t == nt - 2);
            const char* a1 = PG8_AK(cA, t + 1);
            const char* a2 = last ? nA : PG8_AK(cA, t + 2); const char* b2 = last ? nB : cB + (size_t)(t + 2) * kstep;
            const char* a3 = last ? nA + kstep : PG8_AK(cA, t + 3); const char* b3 = b2 + kstep;
            if (last && has_next) S.a_ready(nxt);
            if constexpr (SP2) {
            PG8_LDB(B0, 0, 0); PG8_LDB(B1, 0, 1); PG8_SCHED; PG8_LDA(At, 0, 0); PG8_STAGE(PG8_SA(1, 1), a1 + hstepA, voffA);
            PG8_WAIT_V(8); PG8_WAIT_L(0); PG8_BAR; PG8_MMA(0, 0, At, B0); PG8_MMA(0, 1, At, B1); PG8_BAR; PG8_SCHED;
            PG8_LDA(At, 0, 1); PG8_STAGE(PG8_SB(0, 0), b2, voffB); PG8_STAGE(PG8_SB(0, 1), b2 + hstep, voffB); PG8_STAGE(PG8_SA(0, 0), a2, voffA);
            PG8_WAIT_V(8); PG8_WAIT_L(0); PG8_BAR; PG8_MMA(1, 0, At, B0); PG8_MMA(1, 1, At, B1); PG8_BAR; PG8_SCHED;
            PG8_LDB(B0, 1, 0); PG8_LDB(B1, 1, 1); PG8_SCHED; PG8_LDA(At, 1, 0); PG8_STAGE(PG8_SA(0, 1), a2 + hstepA, voffA);
            PG8_WAIT_V(8); PG8_WAIT_L(0); PG8_BAR; PG8_MMA(0, 0, At, B0); PG8_MMA(0, 1, At, B1); PG8_BAR; PG8_SCHED;
            PG8_LDA(At, 1, 1); PG8_STAGE(PG8_SB(1, 0), b3, voffB); PG8_STAGE(PG8_SB(1, 1), b3 + hstep, voffB); PG8_STAGE(PG8_SA(1, 0), a3, voffA);
            PG8_WAIT_V(8); PG8_WAIT_L(0); PG8_BAR; PG8_MMA(1, 0, At, B0); PG8_MMA(1, 1, At, B1); PG8_BAR; PG8_SCHED;
            } else {
            PG8_LDB(B0, 0, 0); PG8_SCHED; PG8_LDA(At, 0, 0); PG8_STAGE(PG8_SA(1, 1), a1 + hstepA, voffA);
            PG8_WAIT_L(8); PG8_BAR; PG8_WAIT_L(0); PG8_MMA(0, 0, At, B0); PG8_BAR; PG8_SCHED;
            PG8_LDB(B1, 0, 1); PG8_STAGE(PG8_SB(0, 0), b2, voffB);
            PG8_BAR; PG8_WAIT_L(0); PG8_MMA(0, 1, At, B1); PG8_BAR;
            PG8_LDA(At, 0, 1); PG8_STAGE(PG8_SA(0, 0), a2, voffA);
            PG8_BAR; PG8_WAIT_L(0); PG8_MMA(1, 0, At, B0); PG8_BAR; PG8_SCHED;
            PG8_STAGE(PG8_SB(0, 1), b2 + hstep, voffB);
            PG8_WAIT_V(6); PG8_BAR; PG8_MMA(1, 1, At, B1); PG8_BAR;
            PG8_LDB(B0, 1, 0); PG8_SCHED; PG8_LDA(At, 1, 0); PG8_STAGE(PG8_SA(0, 1), a2 + hstepA, voffA);
            PG8_WAIT_L(8); PG8_BAR; PG8_WAIT_L(0); PG8_MMA(0, 0, At, B0); PG8_BAR; PG8_SCHED;
            PG8_LDB(B1, 1, 1); PG8_STAGE(PG8_SB(1, 0), b3, voffB);
            PG8_BAR; PG8_WAIT_L(0); PG8_MMA(0, 1, At, B1); PG8_BAR;
            PG8_LDA(At, 1, 1); PG8_STAGE(PG8_SA(1, 0), a3, voffA);
            PG8_BAR; PG8_WAIT_L(0); PG8_MMA(1, 0, At, B0); PG8_BAR; PG8_SCHED;
            PG8_STAGE(PG8_SB(1, 1), b3 + hstep, voffB);
            PG8_WAIT_V(6); PG8_BAR; PG8_MMA(1, 1, At, B1); PG8_BAR;
            }
        }
        if constexpr (ALIGN_EPI) { if (wr == 0) PG8_BAR; }
        if constexpr (!Epi::AFTER_DRAIN) { E(acc, cur, wr, wc, fr, fq); S.done(cur); }
        if (!has_next) break;
#pragma unroll
        for (int a = 0; a < 2; ++a)
#pragma unroll
            for (int b = 0; b < 2; ++b)
#pragma unroll
                for (int m = 0; m < 4; ++m)
#pragma unroll
                    for (int n = 0; n < 2; ++n) acc[a][b][m][n] = (f32x4){0.f, 0.f, 0.f, 0.f};
        cur = nxt; cA = nA; cB = nB; ++ui;
        if constexpr (ALIGN_EPI) { if (wr == 1) PG8_BAR; }
    }
    PG8_WAIT_V(0);
    if constexpr (!ALIGN_EPI) { if (wr == 0) PG8_BAR; }
    PG8_BAR;
    if constexpr (Epi::AFTER_DRAIN) { E.fused(acc, cur, wr, wc, fr, fq, lds, wid, lane); S.done(cur); }
#undef PG8_AK
#undef PG8_SA
#undef PG8_SB
#undef PG8_STAGE
#undef PG8_LDA
#undef PG8_LDB
#undef PG8_MMA
#undef PG8_WAIT_V
#undef PG8_WAIT_L
#undef PG8_BAR
#undef PG8_SCHED
}
}


constexpr int BATCH = 8, T = 2048, D = 1024, M = BATCH * T, NH = 8, HD = 128, PW = 8208, N1 = 8192, KMIX = 2048, CH = 64, NCH = T / CH;
constexpr int NITEM = BATCH * NCH * NH;
constexpr float EPS = 1e-6f;
constexpr int NWAVES = 8;
constexpr size_t MiB = 1u << 20;
constexpr size_t WS_WIN = 1 * MiB;
constexpr size_t WS_WOUT = 17 * MiB;
constexpr size_t WS_G = 21 * MiB;
constexpr size_t WS_BETA = WS_G + 512 * 1024;
constexpr size_t WS_HALO = 22 * MiB;
constexpr size_t WS_EGL = 27 * MiB;
constexpr size_t WS_SSQ = 28 * MiB;
constexpr size_t WS_HB = 32 * MiB;
constexpr size_t WS_ACT = 64 * MiB;
constexpr size_t ACTSZ = (size_t)M * 1024;
constexpr size_t WS_END = 256 * MiB;
static_assert(WS_ACT + 6 * ACTSZ * 2 == WS_END, "ws map");
constexpr int LDS_BYTES = 147456;

#define LAS __attribute__((address_space(3)))
#define DI __device__ __forceinline__
typedef unsigned short bf16;
typedef unsigned v4u __attribute__((ext_vector_type(4)));
typedef unsigned v2u __attribute__((ext_vector_type(2)));
typedef float f32x4 __attribute__((ext_vector_type(4)));
typedef float f32x2 __attribute__((ext_vector_type(2)));
typedef short bf16x8 __attribute__((ext_vector_type(8)));
using pg8::cvt_pk_bf16;
using pg8::cvt_pk_bf16_v;
using pg8::silu_f;
DI float bf_lo(unsigned u) { return __uint_as_float(u << 16); }
DI float bf_hi(unsigned u) { return __uint_as_float(u & 0xffff0000u); }
#define DPP_MOV(x, ctrl) __int_as_float(__builtin_amdgcn_mov_dpp(__float_as_int(x), (ctrl), 0xF, 0xF, true))
#define DPP_UPD0(x, ctrl, rmask) __int_as_float(__builtin_amdgcn_update_dpp(0, __float_as_int(x), (ctrl), (rmask), 0xF, false))
DI float row16_sum(float v) { v += DPP_MOV(v, 0xB1); v += DPP_MOV(v, 0x4E); v += DPP_MOV(v, 0x141); v += DPP_MOV(v, 0x140); return v; }
DI float wave_sum(float v) {
    v = row16_sum(v);
    v += DPP_UPD0(v, 0x142, 0xA);
    v += DPP_UPD0(v, 0x143, 0xC);
    return __int_as_float(__builtin_amdgcn_readlane(__float_as_int(v), 63));
}
DI int posf(int idx) { return (idx & ~31) | (((idx >> 2) & 3) << 3) | (((idx >> 4) & 1) << 2) | (idx & 3); }
constexpr int permf(int p) { return (p & ~31) | (((p >> 2) & 1) << 4) | (((p >> 3) & 3) << 2) | (p & 3); }
#define LDSV(T, name, src) unsigned name##_u = (unsigned)(size_t)(src); asm volatile("" : "+v"(name##_u)); T name = (T)name##_u
#ifndef DBG_NO_HALO
#define DBG_NO_HALO 0
#endif
#define MFMA16(a, b, c) __builtin_amdgcn_mfma_f32_16x16x32_bf16((a), (b), (c), 0, 0, 0)

struct Args { const float* in[11]; float* out; unsigned char* ws; };

#define XB_TMO      128
#define XB_XCNT(j)  (256  + 64 * (j))
#define XB_XSUB(j)  (1280 + 64 * (j))
#define XB_XGEN(j)  (2304 + 64 * (j))
#define XB_TOP      3328
#define XB_TOPGEN   3392
#define XCD_BAR_WORDS 3456
#define XB_SPIN_CAP (1u << 18)

__device__ __forceinline__ unsigned xb_ld(unsigned* p)              { return __hip_atomic_load(p, __ATOMIC_RELAXED, __HIP_MEMORY_SCOPE_AGENT); }
__device__ __forceinline__ unsigned xb_add(unsigned* p, unsigned v) { return __hip_atomic_fetch_add(p, v, __ATOMIC_RELAXED, __HIP_MEMORY_SCOPE_AGENT); }
__device__ __forceinline__ unsigned xb_xcc_id() { return (unsigned)__builtin_amdgcn_s_getreg((3 << 11) | 20) & 0xFu; }
#define XB_SPIN(cond, bar) do { unsigned _sp = 0; while (cond) { __builtin_amdgcn_s_sleep(1); \
    if ((++_sp & 255u) == 0u) { if (xb_ld(&(bar)[XB_TMO])) break; if (_sp > XB_SPIN_CAP) { atomicAdd(&(bar)[XB_TMO], 1u); break; } } } } while (0)

struct XcdBarrier {
    unsigned* bar; unsigned x;
    volatile LAS unsigned* st;
};

__device__ __forceinline__ XcdBarrier xcd_barrier_post(unsigned* bar, volatile LAS unsigned* st) {
    XcdBarrier b; b.bar = bar; b.x = xb_xcc_id(); b.st = st;
    if (threadIdx.x == 0) (void)xb_add(&bar[XB_XCNT(b.x)], 1u);
    return b;
}
__device__ __forceinline__ void xcd_barrier_complete(unsigned* bar, unsigned x, unsigned& nloc, unsigned& nx) {
    const unsigned G = gridDim.x * gridDim.y * gridDim.z;
    unsigned sum, cnt, mine, sp = 0u;
    for (;;) {
        sum = 0u; cnt = 0u; mine = 0u;
#pragma unroll
        for (unsigned j = 0; j < 16; ++j) { const unsigned c = xb_ld(&bar[XB_XCNT(j)]); sum += c; cnt += (c > 0u) ? 1u : 0u; mine = (j == x) ? c : mine; }
        if (sum == G) break;
        __builtin_amdgcn_s_sleep(1);
        if ((++sp & 255u) == 0u) { if (xb_ld(&bar[XB_TMO])) break; if (sp > XB_SPIN_CAP) { atomicAdd(&bar[XB_TMO], 1u); break; } }
    }
    nloc = mine > 0u ? mine : 1u; nx = cnt > 0u ? cnt : 1u;
}

__device__ __forceinline__ void xcd_barrier(const XcdBarrier& b) {
    asm volatile("s_waitcnt vmcnt(0)" ::: "memory");
    __syncthreads();
    if (threadIdx.x == 0) {
        unsigned* bar = b.bar;
        __builtin_amdgcn_s_waitcnt(0);
        unsigned nloc = b.st[0], nx = b.st[1];
        if (nloc == 0u) { xcd_barrier_complete(bar, b.x, nloc, nx); b.st[0] = nloc; b.st[1] = nx; }
        const unsigned old = xb_add(&bar[XB_XSUB(b.x)], 1u);
        const unsigned gen = old / nloc;
        if (old + 1u == (gen + 1u) * nloc) {
            __builtin_amdgcn_fence(__ATOMIC_RELEASE, "agent");
            asm volatile("s_waitcnt vmcnt(0)" ::: "memory");
            const unsigned og = xb_add(&bar[XB_TOP], 1u);
            const unsigned tg = og / nx;
            if (og + 1u == (tg + 1u) * nx) xb_add(&bar[XB_TOPGEN], 1u);
            else XB_SPIN(xb_ld(&bar[XB_TOPGEN]) == tg, bar);
            __builtin_amdgcn_fence(__ATOMIC_ACQUIRE, "agent");
            xb_add(&bar[XB_XGEN(b.x)], 1u);
            asm volatile("s_waitcnt vmcnt(0)" ::: "memory");
        } else {
            XB_SPIN(xb_ld(&bar[XB_XGEN(b.x)]) == gen, bar);
            __builtin_amdgcn_fence(__ATOMIC_ACQUIRE, "agent");
            asm volatile("s_waitcnt vmcnt(0)" ::: "memory");
        }
    }
    __syncthreads();
}


DI int srccol(int n0) {
    if (n0 < 4096) return n0;
    if (n0 < 6144) { const int r = n0 - 4096, tau = r >> 8, w = r & 255; return w < 128 ? 5136 + 128 * tau + w : 6160 + 128 * tau + (w - 128); }
    const int r = n0 - 6144, tau = r >> 8, w = r & 255; return w < 128 ? 4112 + 128 * tau + w : 7184 + 128 * tau + (w - 128);
}
DI void transpose_item(const float* W, int ldw, int srccol0, bf16* WT, int K, int n0, int k0, LAS float* scr, int lane) {
    f32x4 ld[8];
#pragma unroll
    for (int i = 0; i < 8; ++i) { const int pc = lane + 64 * i, kk = pc >> 3, n4 = pc & 7; ld[i] = *(const f32x4*)(W + (size_t)(k0 + kk) * ldw + srccol0 + 4 * n4); }
#pragma unroll
    for (int i = 0; i < 8; ++i) { const int pc = lane + 64 * i, kk = pc >> 3, n4 = pc & 7; LAS float* d = scr + kk * 33 + 4 * n4; d[0] = ld[i].x; d[1] = ld[i].y; d[2] = ld[i].z; d[3] = ld[i].w; }
    asm volatile("s_waitcnt lgkmcnt(0)" ::: "memory");
    const int c = lane & 7;
#pragma unroll
    for (int j = 0; j < 4; ++j) { const int n = (lane >> 3) + 8 * j; const LAS float* s = scr + (8 * c) * 33 + n;
        v4u o; o.x = cvt_pk_bf16(s[0 * 33], s[1 * 33]); o.y = cvt_pk_bf16(s[2 * 33], s[3 * 33]); o.z = cvt_pk_bf16(s[4 * 33], s[5 * 33]); o.w = cvt_pk_bf16(s[6 * 33], s[7 * 33]);
        *(v4u*)(WT + (size_t)(n0 + n) * K + k0 + 8 * c) = o; }
    asm volatile("s_waitcnt lgkmcnt(0)" ::: "memory");
}
DI void p0_prologue(const Args& a, LAS unsigned char* lds, int vcu, int G, int tid, int lane, int wave) {
    unsigned char* ws = a.ws;
    const float* x = a.in[0]; const float* norm_w = a.in[1]; const float* w_in = a.in[2]; const float* A_log = a.in[4]; const float* dt_bias = a.in[5]; const float* w_out = a.in[9];
    bf16* WinT = (bf16*)(ws + WS_WIN); bf16* WoutT = (bf16*)(ws + WS_WOUT); bf16* HB = (bf16*)(ws + WS_HB);
    float* Gb = (float*)(ws + WS_G); float* Bb = (float*)(ws + WS_BETA);
    LAS float* scr = (LAS float*)(lds + wave * 16384);
    const int gw = vcu * NWAVES + wave, NGW = G * NWAVES;
    constexpr int I_IN = (D / 64) * (N1 / 32), I_OUT = (KMIX / 64) * (D / 32);
#define P0_LOAD(dst, mb) do { _Pragma("unroll") for (int u = 0; u < 4; ++u) { const f32x4* xr_ = (const f32x4*)(x + (size_t)min((mb) + u * NGW, M - 1) * D) + lane; \
        _Pragma("unroll") for (int j = 0; j < 4; ++j) dst[u][j] = xr_[64 * j]; } } while (0)
    f32x4 vv[4][4], vnx[4][4];
    P0_LOAD(vv, gw);
    for (int it = gw; it < I_IN + I_OUT; it += NGW) {
        if (it < I_IN) { const int kb = it / (N1 / 32), nb = it % (N1 / 32); transpose_item(w_in, PW, srccol(32 * nb), WinT, D, 32 * nb, 64 * kb, scr, lane); }
        else { const int r = it - I_IN, kb = r / (D / 32), nb = r % (D / 32); transpose_item(w_out, D, 32 * nb, WoutT, KMIX, 32 * nb, 64 * kb, scr, lane); }
    }
    __syncthreads();
    LAS float* wbg = (LAS float*)lds;
    {   float tmpw[32];
#pragma unroll
        for (int i = 0; i < 32; ++i) { const int idx = tid + 512 * i, k = idx >> 4, c = idx & 15; tmpw[i] = w_in[(size_t)k * PW + 4096 + c]; }
#pragma unroll
        for (int i = 0; i < 32; ++i) { const int idx = tid + 512 * i, k = idx >> 4, c = idx & 15; wbg[c * 1024 + k] = tmpw[i]; } }
    __syncthreads();
    const LAS f32x4* wb4 = (const LAS f32x4*)wbg;
    f32x4 nw[4];
#pragma unroll
    for (int j = 0; j < 4; ++j) nw[j] = ((const f32x4*)norm_w)[lane + 64 * j];
    for (int m0 = gw; m0 < M; m0 += 4 * NGW) {
        int mr[4];
#pragma unroll
        for (int u = 0; u < 4; ++u) mr[u] = min(m0 + u * NGW, M - 1);
        if (m0 + 4 * NGW < M) P0_LOAD(vnx, m0 + 4 * NGW);
#pragma unroll
        for (int u = 0; u < 4; ++u) { float s = 0.f;
#pragma unroll
            for (int j = 0; j < 4; ++j) s += (vv[u][j].x * vv[u][j].x + vv[u][j].y * vv[u][j].y) + (vv[u][j].z * vv[u][j].z + vv[u][j].w * vv[u][j].w);
            const float rstd = __builtin_amdgcn_rsqf(wave_sum(s) * (1.f / D) + EPS);
            unsigned long long* o8 = (unsigned long long*)(HB + (size_t)mr[u] * D) + lane;
#pragma unroll
            for (int j = 0; j < 4; ++j) { vv[u][j] = vv[u][j] * rstd * nw[j];
                o8[64 * j] = (unsigned long long)cvt_pk_bf16(vv[u][j].x, vv[u][j].y) | ((unsigned long long)cvt_pk_bf16(vv[u][j].z, vv[u][j].w) << 32); } }
        float ds[64];
#pragma unroll
        for (int c = 0; c < 16; ++c) { f32x2 d2[4] = {{0.f, 0.f}, {0.f, 0.f}, {0.f, 0.f}, {0.f, 0.f}};
#pragma unroll
            for (int j = 0; j < 4; ++j) { const f32x4 w = wb4[c * 256 + lane + 64 * j]; const f32x2 w01 = {w.x, w.y}, w23 = {w.z, w.w};
#pragma unroll
                for (int u = 0; u < 4; ++u) { d2[u] = d2[u] + (f32x2){vv[u][j].x, vv[u][j].y} * w01; d2[u] = d2[u] + (f32x2){vv[u][j].z, vv[u][j].w} * w23; } }
#pragma unroll
            for (int u = 0; u < 4; ++u) ds[16 * u + c] = d2[u].x + d2[u].y; }
#pragma unroll
        for (int o = 32; o >= 1; o >>= 1) { const bool up = (lane & o) != 0;
#pragma unroll
            for (int k = 0; k < o; ++k) { const float lo = ds[k], hi = ds[k + o]; const float send = up ? lo : hi, keep = up ? hi : lo; ds[k] = keep + __shfl_xor(send, o); } }
        {   const float sel = ds[0]; const int u = lane >> 4, c = lane & 15; const int m = (u == 0) ? mr[0] : (u == 1 ? mr[1] : (u == 2 ? mr[2] : mr[3]));
            if (c < 8) Bb[(size_t)m * 8 + c] = 1.f / (1.f + expf(-sel));
            else { const int h = c - 8; const float xx = sel + dt_bias[h]; const float sp = fmaxf(xx, 0.f) + log1pf(expf(-fabsf(xx))); Gb[(size_t)m * 8 + h] = -expf(A_log[h]) * sp; } }
#pragma unroll
        for (int u = 0; u < 4; ++u)
#pragma unroll
            for (int j = 0; j < 4; ++j) vv[u][j] = vnx[u][j];
    }
#undef P0_LOAD
}

constexpr int KN_STRIDE = 136;
constexpr int AT_STRIDE = 68;
constexpr int PA_KN = 0, PA_QN = 64 * KN_STRIDE * 2, PA_AT = 2 * PA_QN, PA_VH = PA_AT + 64 * AT_STRIDE * 4, PA_SM = PA_VH + 64 * KN_STRIDE * 2, PA_ITEM_LDS = PA_SM + 1024;
static_assert(2 * PA_ITEM_LDS <= LDS_BYTES, "PA LDS");

DI void tri_solve(f32x2 (&X)[64], const LAS float* A) {
#ifdef DBG_NO_SOLVE
    return;
#endif
    const unsigned a_u = (unsigned)(size_t)A;
#pragma unroll
    for (int i = 1; i < 64; ++i) {
        unsigned ai = a_u + i * AT_STRIDE * 4;
        asm volatile("" : "+v"(ai) : "v"(X[(i < 32) ? (i >= 2 ? i - 2 : 0) : i - 1].x));
        const LAS float* rowp = (const LAS float*)ai;
        f32x2 acc[4] = {X[i], {0.f, 0.f}, {0.f, 0.f}, {0.f, 0.f}};
#pragma unroll
        for (int j4 = 0; 4 * j4 < i; ++j4) {
            const f32x4 av = *(const LAS f32x4*)(rowp + 4 * j4);
            acc[0] = acc[0] - X[4 * j4] * av.x;
            if (4 * j4 + 1 < i) acc[1] = acc[1] - X[4 * j4 + 1] * av.y;
            if (4 * j4 + 2 < i) acc[2] = acc[2] - X[4 * j4 + 2] * av.z;
            if (4 * j4 + 3 < i) acc[3] = acc[3] - X[4 * j4 + 3] * av.w;
        }
        X[i] = (acc[0] + acc[1]) + (acc[2] + acc[3]);
    }
}

DI void pa_phase(const Args& a, LAS unsigned char* lds, int G, int tid, int lane, int wave) {
    unsigned char* ws = a.ws;
    const float* conv_qkv_w = a.in[3];
    bf16* ACT = (bf16*)(ws + WS_ACT); const bf16* HALO = (const bf16*)(ws + WS_HALO); bf16* Wb = (bf16*)(ws + WS_HB);
    const float* Gb = (const float*)(ws + WS_G); const float* Bb = (const float*)(ws + WS_BETA); float* EGL = (float*)(ws + WS_EGL);
    bf16* ATTN = (bf16*)a.out;
    const int sg = wave >> 2, role = (wave & 3) ^ (sg << 1), tsg = tid & 255;
    LAS unsigned char* base = lds + sg * PA_ITEM_LDS;
    LAS unsigned char* KnB = base + PA_KN; LAS unsigned char* QnB = base + PA_QN; LAS unsigned char* ATB = base + PA_AT; LAS unsigned char* VhB = base + PA_VH;
    LAS bf16* Kn = (LAS bf16*)KnB; LAS bf16* Qn = (LAS bf16*)QnB; LAS float* AT = (LAS float*)ATB; LAS float* sm = (LAS float*)(base + PA_SM);
#ifdef DBG_NO_ITEMS
    const int nrounds = 0;
#else
    const int nrounds = (NITEM + 2 * G - 1) / (2 * G);
#endif
    for (int round = 0; round < nrounds; ++round) {
        int ln, tsl;
        const int item = (round * G + (int)blockIdx.x) * 2 + sg; const bool valid = item < NITEM;
        const int h = item & 7, c = (item >> 3) & 31, b = item >> 8; const size_t row0 = (size_t)b * T + (size_t)c * CH;
        ln = lane; tsl = tsg; asm volatile("" : "+v"(ln), "+v"(tsl));
        if (valid) {
            const int seg = tsl & 15, rr0 = tsl >> 4;
            const bf16* hb_ = HALO + ((size_t)(b * NCH + c - 1) * 3) * 3072 + h * HD + seg * 8;
            const bf16* gb_ = ACT + row0 * 1024 + h * HD + seg * 8;
#pragma unroll
            for (int tens = 0; tens < 3; ++tens) {
                LAS unsigned char* dreg = (tens == 0 ? QnB : (tens == 1 ? KnB : ATB)) + seg * 16;
                v4u v[5];
#pragma unroll
                for (int k = 0; k < 5; ++k) { const int rr = rr0 + 16 * k; v[k] = (v4u){0u, 0u, 0u, 0u};
                    if (rr < 67) { if (rr >= 3) v[k] = *(const v4u*)(gb_ + (size_t)tens * ACTSZ + (size_t)(rr - 3) * 1024); else if (c > 0) v[k] = *(const v4u*)(hb_ + (size_t)rr * 3072 + tens * 1024); } }
#pragma unroll
                for (int k = 0; k < 5; ++k) { const int rr = rr0 + 16 * k; if (rr < 67) *(LAS v4u*)(dreg + rr * 256) = v[k]; }
            }
        }
        __syncthreads();
        ln = lane; tsl = tsg; asm volatile("" : "+v"(ln), "+v"(tsl));
        if (valid && role < 3) {
            const int ti = (role == 0) ? 2 : (role == 1 ? 1 : 0);
            const LAS unsigned* rp = (const LAS unsigned*)(role == 0 ? ATB : (role == 1 ? KnB : QnB)) + ln;
            const float* cwp = conv_qkv_w + ti * 1024 + h * HD + 2 * ln;
            f32x2 cw[4];
#pragma unroll
            for (int j = 0; j < 4; ++j) { cw[j].x = cwp[j * 3072]; cw[j].y = cwp[j * 3072 + 1]; }
            f32x2 val[64];
            unsigned x0 = rp[0], x1 = rp[64], x2 = rp[128];
#pragma unroll
            for (int i = 0; i < 64; ++i) { const unsigned x3 = rp[(i + 3) * 64];
                f32x2 s;
                s.x = cw[0].x * bf_lo(x0) + cw[1].x * bf_lo(x1) + cw[2].x * bf_lo(x2) + cw[3].x * bf_lo(x3);
                s.y = cw[0].y * bf_hi(x0) + cw[1].y * bf_hi(x1) + cw[2].y * bf_hi(x2) + cw[3].y * bf_hi(x3);
#ifdef DBG_COPY_V
                val[i].x = bf_lo(x3); val[i].y = bf_hi(x3);
#else
                val[i].x = silu_f(s.x); val[i].y = silu_f(s.y);
#endif
                x0 = x1; x1 = x2; x2 = x3; }
            LAS unsigned* dst = (LAS unsigned*)(role == 0 ? VhB : (role == 1 ? KnB : QnB)) + ln;
            if (role != 0) {
                const float sc = (role == 2) ? 0.08838834764831845f : 1.f;
#pragma unroll
                for (int hb = 0; hb < 64; hb += 32) {
                    float ssq[32];
#pragma unroll
                    for (int i = 0; i < 32; ++i) ssq[i] = val[hb + i].x * val[hb + i].x + val[hb + i].y * val[hb + i].y;
#pragma unroll
                    for (int i = 0; i < 32; ++i) ssq[i] += DPP_MOV(ssq[i], 0xB1);
#pragma unroll
                    for (int i = 0; i < 32; ++i) ssq[i] += DPP_MOV(ssq[i], 0x4E);
#pragma unroll
                    for (int i = 0; i < 32; ++i) ssq[i] += DPP_MOV(ssq[i], 0x141);
#pragma unroll
                    for (int i = 0; i < 32; ++i) ssq[i] += DPP_MOV(ssq[i], 0x140);
#pragma unroll
                    for (int i = 0; i < 32; ++i) ssq[i] += DPP_UPD0(ssq[i], 0x142, 0xA);
#pragma unroll
                    for (int i = 0; i < 32; ++i) ssq[i] += DPP_UPD0(ssq[i], 0x143, 0xC);
#pragma unroll
                    for (int i = 0; i < 32; ++i) { const float tot = __int_as_float(__builtin_amdgcn_readlane(__float_as_int(ssq[i]), 63)); const float rs = sc * __builtin_amdgcn_rsqf(tot + EPS);
                        dst[(hb + i) * (KN_STRIDE / 2)] = cvt_pk_bf16(val[hb + i].x * rs, val[hb + i].y * rs); }
                    __builtin_amdgcn_sched_barrier(0);
                }
            } else {
#pragma unroll
                for (int i = 0; i < 64; ++i) dst[i * (KN_STRIDE / 2)] = cvt_pk_bf16(val[i].x, val[i].y);
            }
        } else if (valid) {
#ifdef DBG_CONST_GATES
            float v = -0.05f; const float bi = 0.5f;
#else
            float v = Gb[(row0 + ln) * 8 + h]; const float bi = Bb[(row0 + ln) * 8 + h];
#endif
#pragma unroll
            for (int o = 1; o < 64; o <<= 1) { const float t = __shfl_up(v, o); if (ln >= o) v += t; }
            const float gl = __shfl(v, 63);
            sm[ln] = v; sm[64 + ln] = bi; sm[128 + ln] = __expf(v); sm[192 + ln] = __expf(gl - v);
            if (ln == 63) EGL[item] = __expf(v);
        }
        __syncthreads();
        ln = lane; tsl = tsg; asm volatile("" : "+v"(ln), "+v"(tsl));
        if (valid) {
            const int r = ln & 15, q = ln >> 4, ti_ = role;
            LDSV(LAS float*, smv, sm); LDSV(LAS float*, ATv, AT); LDSV(LAS bf16*, Knv, Kn); LDSV(LAS bf16*, Qnv, Qn);
            bf16x8 ki[4], qi[4];
#pragma unroll
            for (int s = 0; s < 4; ++s) { ki[s] = *(const LAS bf16x8*)(Knv + (16 * ti_ + r) * KN_STRIDE + 32 * s + 8 * q); qi[s] = *(const LAS bf16x8*)(Qnv + (16 * ti_ + r) * KN_STRIDE + 32 * s + 8 * q); }
            bf16* attn_i = ATTN + (size_t)item * 4096 + (16 * ti_ + r) * 64 + 8 * q;
            const float gci2 = smv[16 * ti_ + r], bi2 = smv[64 + 16 * ti_ + r];
#pragma unroll
            for (int tj = 0; tj < 4; ++tj) {
                bf16* ap = attn_i + 32 * (tj >> 1) + 4 * (tj & 1);
                if (tj <= ti_) {
                    f32x4 c1 = {0.f, 0.f, 0.f, 0.f}, c2 = {0.f, 0.f, 0.f, 0.f};
#pragma unroll
                    for (int s = 0; s < 4; ++s) { const bf16x8 kj = *(const LAS bf16x8*)(Knv + (16 * tj + r) * KN_STRIDE + 32 * s + 8 * q); c1 = MFMA16(kj, ki[s], c1); c2 = MFMA16(kj, qi[s], c2); }
                    const int i2 = 16 * ti_ + r; float p[4];
                    f32x4 o;
#pragma unroll
                    for (int e = 0; e < 4; ++e) { const int j2 = 16 * tj + 4 * q + e; o[e] = (j2 < i2) ? bi2 * __expf(gci2 - smv[j2]) * c1[e] : 0.f; }
                    { v2u na; na.x = cvt_pk_bf16(-o[0], -o[1]); na.y = cvt_pk_bf16(-o[2], -o[3]); *(LAS v2u*)((LAS unsigned char*)ATv + i2 * 144 + (16 * tj + 4 * q) * 2) = na; }
                    if (tj == ti_) *(LAS f32x4*)((LAS unsigned char*)ATv + 9216 + ((ti_ * 16 + r) * 16 + 4 * q) * 4) = o;
#pragma unroll
                    for (int e = 0; e < 4; ++e) { const int j2 = 16 * tj + 4 * q + e; p[e] = (j2 <= i2) ? __expf(gci2 - smv[j2]) * c2[e] : 0.f; }
                    v2u w; w.x = cvt_pk_bf16(p[0], p[1]); w.y = cvt_pk_bf16(p[2], p[3]); *(v2u*)ap = w;
                } else { v2u w; w.x = 0u; w.y = 0u; *(v2u*)ap = w; }
            }
        }
        __syncthreads();
        ln = lane; tsl = tsg; asm volatile("" : "+v"(ln), "+v"(tsl));
        if (valid) {
            LDSV(LAS float*, smv, sm); LDSV(LAS unsigned char*, QnBv, QnB); LDSV(LAS bf16*, Knv, Kn);
            for (int pc = tsl; pc < 1024; pc += 256) {
                const int i = pc >> 4, sg8 = pc & 15, s = sg8 >> 2, q = sg8 & 3; const float e = smv[128 + i];
                const v2u lo = *(const LAS v2u*)(QnBv + i * 272 + (32 * s + 4 * q) * 2), hi = *(const LAS v2u*)(QnBv + i * 272 + (32 * s + 16 + 4 * q) * 2);
                v4u o; o.x = cvt_pk_bf16(bf_lo(lo.x) * e, bf_hi(lo.x) * e); o.y = cvt_pk_bf16(bf_lo(lo.y) * e, bf_hi(lo.y) * e); o.z = cvt_pk_bf16(bf_lo(hi.x) * e, bf_hi(hi.x) * e); o.w = cvt_pk_bf16(bf_lo(hi.y) * e, bf_hi(hi.y) * e);
                *(v4u*)(ACT + (row0 + i) * 1024 + h * HD + sg8 * 8) = o; }
            for (int pc = tsl; pc < 1024; pc += 256) {
                const int dk = pc >> 3, g = pc & 7, s = g >> 2, q = g & 3; float f[8];
#pragma unroll
                for (int e = 0; e < 8; ++e) { const int j = 32 * s + 16 * (e >> 2) + 4 * q + (e & 3); f[e] = __uint_as_float((unsigned)Knv[j * KN_STRIDE + dk] << 16) * smv[192 + j]; }
                v4u o; o.x = cvt_pk_bf16(f[0], f[1]); o.y = cvt_pk_bf16(f[2], f[3]); o.z = cvt_pk_bf16(f[4], f[5]); o.w = cvt_pk_bf16(f[6], f[7]);
                *(v4u*)(ACT + ACTSZ + (row0 + (dk >> 1)) * 1024 + h * HD + (dk & 1) * 64 + g * 8) = o; }
        }
        __syncthreads();
        ln = lane; tsl = tsg; asm volatile("" : "+v"(ln), "+v"(tsl));
        f32x4 Rv[4][4];
        const int cbase = 64 * (role & 1);
        if (valid) {
            LDSV(LAS float*, smv, sm);
            const int r = ln & 15, q = ln >> 4;
            const LAS bf16* tile = (const LAS bf16*)(role < 2 ? VhB : KnB);
#pragma unroll
            for (int bb = 0; bb < 4; ++bb)
#pragma unroll
                for (int e = 0; e < 4; ++e) { const int row = 16 * bb + 4 * q + e; const float be = smv[64 + row], eg = smv[128 + row]; const float f = (role < 2) ? be : be * eg;
#pragma unroll
                    for (int nt = 0; nt < 4; ++nt) Rv[nt][bb][e] = __uint_as_float((unsigned)tile[row * KN_STRIDE + cbase + 16 * nt + r] << 16) * f; }
        }
        __syncthreads();
        ln = lane; tsl = tsg; asm volatile("" : "+v"(ln), "+v"(tsl));
        if (valid) {
            LAS unsigned char* XT = (role < 2 ? VhB : KnB);
            {   LAS unsigned char* zp = XT + cbase * 136 + ln * 16;
                const v4u z4 = {0u, 0u, 0u, 0u};
#pragma unroll
                for (int k = 0; k < 8; ++k) *(LAS v4u*)(zp + 1024 * k) = z4;
                if (ln < 32) *(LAS v4u*)(zp + 8192) = z4; }
            if (role == 0) {
                LDSV(LAS unsigned char*, ATu, ATB);
                const int tb = ln >> 4, tc = ln & 15;
                const LAS float* adg = (const LAS float*)(ATu + 9216) + tb * 256;
                float t[16];
#pragma unroll
                for (int i = 0; i < 16; ++i) { float acc = (tc == i) ? 1.f : 0.f;
#pragma unroll
                    for (int j4 = 0; 4 * j4 < i; ++j4) { const f32x4 av = *(const LAS f32x4*)(adg + i * 16 + 4 * j4);
                        acc -= av.x * t[4 * j4]; if (4 * j4 + 1 < i) acc -= av.y * t[4 * j4 + 1]; if (4 * j4 + 2 < i) acc -= av.z * t[4 * j4 + 2]; if (4 * j4 + 3 < i) acc -= av.w * t[4 * j4 + 3]; }
                    t[i] = acc; }
                LAS unsigned char* tp = ATu + 13312 + tb * 1024 + (8 * (tc >> 2) + (tc & 3)) * 2;
#pragma unroll
                for (int i = 0; i < 16; ++i) { const float to = DPP_MOV(t[i], 0xB1);
                    if ((tc & 1) == 0) *(LAS unsigned*)(tp + i * 64) = cvt_pk_bf16(t[i], to);
                    if ((tc & 3) == 0) { v2u z2; z2.x = 0u; z2.y = 0u; *(LAS v2u*)(tp + i * 64 + 8) = z2; } }
            }
        }
        __syncthreads();
        ln = lane; tsl = tsg; asm volatile("" : "+v"(ln), "+v"(tsl));
        if (valid) {
            LDSV(LAS unsigned char*, ATu, ATB);
            LAS unsigned char* XT = (role < 2 ? VhB : KnB);
            const int r = ln & 15, q = ln >> 4;
            LAS unsigned char* xcol = XT + (cbase + r) * 136;
#pragma unroll
            for (int bb = 0; bb < 4; ++bb) {
                const bf16x8 tf = *(const LAS bf16x8*)(ATu + 13312 + ((bb * 16 + r) * 32 + 8 * q) * 2);
                bf16x8 af[2];
#pragma unroll
                for (int ks = 0; ks < 2; ++ks) if (32 * ks < 16 * bb) af[ks] = *(const LAS bf16x8*)(ATu + (16 * bb + r) * 144 + (32 * ks + 8 * q) * 2);
#pragma unroll
                for (int nt = 0; nt < 4; ++nt) {
                    f32x4 acc = Rv[nt][bb];
#pragma unroll
                    for (int ks = 0; ks < 2; ++ks) if (32 * ks < 16 * bb) {
                        const v2u lo = *(const LAS v2u*)(xcol + nt * (16 * 136) + (32 * ks + 8 * q) * 2), hi = *(const LAS v2u*)(xcol + nt * (16 * 136) + (32 * ks + 8 * q) * 2 + 8);
                        v4u bw; bw.x = lo.x; bw.y = lo.y; bw.z = hi.x; bw.w = hi.y;
                        acc = MFMA16(af[ks], __builtin_bit_cast(bf16x8, bw), acc); }
                    v4u rw; rw.x = cvt_pk_bf16_v(acc[0], acc[1]); rw.y = cvt_pk_bf16_v(acc[2], acc[3]); rw.z = 0u; rw.w = 0u;
                    const f32x4 zero4 = {0.f, 0.f, 0.f, 0.f};
                    const f32x4 x = MFMA16(tf, __builtin_bit_cast(bf16x8, rw), zero4);
                    v2u xw; xw.x = cvt_pk_bf16_v(x[0], x[1]); xw.y = cvt_pk_bf16_v(x[2], x[3]);
                    *(LAS v2u*)(xcol + nt * (16 * 136) + (16 * bb + 4 * q) * 2) = xw;
                }
            }
        }
        __syncthreads();
        ln = lane; tsl = tsg; asm volatile("" : "+v"(ln), "+v"(tsl));
        if (valid) {
            for (int pc = tsl; pc < 2048; pc += 256) { const int which = pc >> 10, id = pc & 1023, i = id & 63, seg = id >> 6;
                const LAS bf16* xt = (const LAS bf16*)(which ? KnB : VhB) + i;
                unsigned short v[8];
#pragma unroll
                for (int e = 0; e < 8; ++e) { const int p = seg * 8 + e; const int col = which ? ((p & ~31) | (((p >> 2) & 1) << 4) | (((p >> 3) & 3) << 2) | (p & 3)) : p; v[e] = xt[col * 68]; }
                v4u o; o.x = (unsigned)v[0] | ((unsigned)v[1] << 16); o.y = (unsigned)v[2] | ((unsigned)v[3] << 16); o.z = (unsigned)v[4] | ((unsigned)v[5] << 16); o.w = (unsigned)v[6] | ((unsigned)v[7] << 16);
                bf16* dstp = which ? (Wb + (row0 + i) * 1024 + h * HD + seg * 8) : (ACT + 2 * ACTSZ + (row0 + i) * 1024 + h * HD + seg * 8);
                *(v4u*)dstp = o; }
        }
        __syncthreads();
    }
}

DI void yc_phase(const Args& a, int first, int G, int tid) {
    unsigned char* ws = a.ws; bf16* ACT = (bf16*)(ws + WS_ACT);
    {
        const float* conv_w = a.in[7]; const float* conv_b = a.in[8];
        const bf16* Pb = ACT + 4 * ACTSZ; bf16* Sb = ACT + 5 * ACTSZ;
        const int cgp = tid & 127, rq = tid >> 7, col = cgp * 8;
        float w0[8], w1[8], w2[8], bb[8];
#pragma unroll
        for (int e = 0; e < 8; ++e) { w0[e] = conv_w[col + e]; w1[e] = conv_w[1024 + col + e]; w2[e] = conv_w[2048 + col + e]; bb[e] = conv_b[col + e]; }
        for (int rc = (int)blockIdx.x - first; rc < M / 64; rc += G - first) {
            const size_t r0 = (size_t)rc * 64 + rq * 16;
            v4u pm2 = {0u, 0u, 0u, 0u}, pm1 = {0u, 0u, 0u, 0u};
            if ((r0 & (T - 1)) != 0) { pm2 = *(const v4u*)(Pb + (r0 - 2) * 1024 + col); pm1 = *(const v4u*)(Pb + (r0 - 1) * 1024 + col); }
#pragma unroll 4
            for (int i = 0; i < 16; ++i) {
                const v4u p0 = *(const v4u*)(Pb + (r0 + i) * 1024 + col); const v4u sv = *(const v4u*)(Sb + (r0 + i) * 1024 + col);
                v4u o;
#pragma unroll
                for (int e = 0; e < 4; ++e) {
                    const float ylo = bf_lo(sv[e]) * (w0[2 * e] * bf_lo(pm2[e]) + w1[2 * e] * bf_lo(pm1[e]) + w2[2 * e] * bf_lo(p0[e]) + bb[2 * e]);
                    const float yhi = bf_hi(sv[e]) * (w0[2 * e + 1] * bf_hi(pm2[e]) + w1[2 * e + 1] * bf_hi(pm1[e]) + w2[2 * e + 1] * bf_hi(p0[e]) + bb[2 * e + 1]);
                    o[e] = cvt_pk_bf16(ylo, yhi); }
                *(v4u*)(Sb + (r0 + i) * 1024 + col) = o;
                pm2 = pm1; pm1 = p0;
            }
        }
    }
}

constexpr int PB_W = 0, PB_Q = 64 * 272, PB_K = 2 * 64 * 272, PB_A = 3 * 64 * 272, PB_U = PB_A + 64 * 144, PB_BUF = PB_U + 64 * 144;
static_assert(2 * PB_BUF <= LDS_BYTES - 16, "PB LDS");
DI void pb_phase(const Args& a, LAS unsigned char* lds, int vcu, int G, int tid, int lane, int wave) {
    unsigned char* ws = a.ws;
    bf16* ACT = (bf16*)(ws + WS_ACT); const bf16* Wb = (const bf16*)(ws + WS_HB); const float* EGL = (const float*)(ws + WS_EGL);
    const bf16* ATTN = (const bf16*)a.out;
    const int r = lane & 15, q = lane >> 4;
    for (int unit = blockIdx.x; unit < 2 * BATCH * NH; unit += G) {
        const int half = (unit >> 3) & 1, bh = (unit & 7) + 8 * (unit >> 4), h = bh & 7, b = bh >> 3;
        if (wave >= 4) {
            const int tl = tid - 256;
            v4u st[16];
#define PB_ISSUE(c_) do { const size_t row0_ = (size_t)b * T + (size_t)(c_) * CH; const int item_ = (b * NCH + (c_)) * NH + h; \
                _Pragma("unroll") for (int k = 0; k < 12; ++k) { const int p = tl + 256 * (k & 3), rw = p >> 4, sg_ = p & 15; \
                    const bf16* src = (k < 4 ? Wb : (k < 8 ? (const bf16*)ACT : (const bf16*)(ACT + ACTSZ))) + (row0_ + rw) * 1024 + h * HD + sg_ * 8; st[k] = *(const v4u*)src; } \
                _Pragma("unroll") for (int k = 12; k < 14; ++k) { const int p = tl + 256 * (k - 12); st[k] = *(const v4u*)(ATTN + (size_t)item_ * 4096 + (p >> 3) * 64 + (p & 7) * 8); } \
                _Pragma("unroll") for (int k = 14; k < 16; ++k) { const int p = tl + 256 * (k - 14); st[k] = *(const v4u*)(ACT + 2 * ACTSZ + (row0_ + (p >> 3)) * 1024 + h * HD + 64 * half + (p & 7) * 8); } } while (0)
#define PB_COMMIT(buf_) do { LAS unsigned char* bb_ = lds + (buf_) * PB_BUF; \
                _Pragma("unroll") for (int k = 0; k < 12; ++k) { const int p = tl + 256 * (k & 3), rw = p >> 4, sg_ = p & 15; *(LAS v4u*)(bb_ + (k >> 2) * (64 * 272) + rw * 272 + sg_ * 16) = st[k]; } \
                _Pragma("unroll") for (int k = 12; k < 14; ++k) { const int p = tl + 256 * (k - 12); *(LAS v4u*)(bb_ + PB_A + (p >> 3) * 144 + (p & 7) * 16) = st[k]; } \
                _Pragma("unroll") for (int k = 14; k < 16; ++k) { const int p = tl + 256 * (k - 14); *(LAS v4u*)(bb_ + PB_U + (p >> 3) * 144 + (p & 7) * 16) = st[k]; } } while (0)
            PB_ISSUE(0); PB_COMMIT(0); PB_ISSUE(1);
            __syncthreads();
            for (int c = 0; c < NCH; ++c) {
                if (c + 1 < NCH) PB_COMMIT((c + 1) & 1);
                if (c + 2 < NCH) PB_ISSUE(c + 2);
                __syncthreads();
            }
#undef PB_ISSUE
#undef PB_COMMIT
        } else {
            const int sl = 4 * half + wave;
            f32x4 S[8];
#pragma unroll
            for (int tm = 0; tm < 8; ++tm) S[tm] = (f32x4){0.f, 0.f, 0.f, 0.f};
            __syncthreads();
            for (int c = 0; c < NCH; ++c) {
                const size_t row0 = (size_t)b * T + (size_t)c * CH; const int item = (b * NCH + c) * NH + h;
                const LAS unsigned char* bb = lds + (c & 1) * PB_BUF;
                const LAS unsigned char* wp = bb + PB_W + r * 272 + q * 16;
                const LAS unsigned char* qp = bb + PB_Q + r * 272 + q * 16;
                const LAS unsigned char* kp = bb + PB_K + (r >> 1) * 272 + (r & 1) * 128 + q * 16;
                const LAS unsigned char* ap = bb + PB_A + r * 144 + q * 16;
                const LAS bf16* uq = (const LAS bf16*)(bb + PB_U + (4 * q) * 144) + 16 * wave + r;
                const float egl = EGL[item];
                bf16x8 Sb[4];
#pragma unroll
                for (int s = 0; s < 4; ++s) { v4u w; w.x = cvt_pk_bf16_v(S[2 * s][0], S[2 * s][1]); w.y = cvt_pk_bf16_v(S[2 * s][2], S[2 * s][3]); w.z = cvt_pk_bf16_v(S[2 * s + 1][0], S[2 * s + 1][1]); w.w = cvt_pk_bf16_v(S[2 * s + 1][2], S[2 * s + 1][3]);
                    Sb[s] = __builtin_bit_cast(bf16x8, w); }
                f32x4 vn[4], O[4];
#pragma unroll
                for (int t = 0; t < 4; ++t) {
                    f32x4 p = {0.f, 0.f, 0.f, 0.f}, o = {0.f, 0.f, 0.f, 0.f};
#pragma unroll
                    for (int s = 0; s < 4; ++s) { const bf16x8 wf = *(const LAS bf16x8*)(wp + t * (16 * 272) + s * 64); const bf16x8 qf = *(const LAS bf16x8*)(qp + t * (16 * 272) + s * 64);
                        p = MFMA16(wf, Sb[s], p); o = MFMA16(qf, Sb[s], o); }
#pragma unroll
                    for (int e = 0; e < 4; ++e) vn[t][e] = __uint_as_float((unsigned)uq[(16 * t + e) * 72] << 16) - p[e];
                    O[t] = o;
                }
                bf16x8 vb[2];
#pragma unroll
                for (int s = 0; s < 2; ++s) { v4u w; w.x = cvt_pk_bf16_v(vn[2 * s][0], vn[2 * s][1]); w.y = cvt_pk_bf16_v(vn[2 * s][2], vn[2 * s][3]); w.z = cvt_pk_bf16_v(vn[2 * s + 1][0], vn[2 * s + 1][1]); w.w = cvt_pk_bf16_v(vn[2 * s + 1][2], vn[2 * s + 1][3]);
                    vb[s] = __builtin_bit_cast(bf16x8, w); }
#pragma unroll
                for (int t = 0; t < 4; ++t) {
#pragma unroll
                    for (int s = 0; s < 2; ++s) { const bf16x8 af = *(const LAS bf16x8*)(ap + t * (16 * 144) + s * 64); O[t] = MFMA16(af, vb[s], O[t]); }
                }
#pragma unroll
                for (int tm = 0; tm < 8; ++tm) {
                    f32x4 acc = S[tm] * egl;
#pragma unroll
                    for (int s = 0; s < 2; ++s) { const bf16x8 kf = *(const LAS bf16x8*)(kp + tm * (8 * 272) + s * 64); acc = MFMA16(kf, vb[s], acc); }
                    S[tm] = acc;
                }
                bf16* up = ACT + 2 * ACTSZ + (row0 + 4 * q) * 1024 + h * HD + 16 * sl + r;
#pragma unroll
                for (int t = 0; t < 4; ++t)
#pragma unroll
                    for (int e = 0; e < 4; ++e) up[(size_t)(16 * t + e) * 1024] = (bf16)(cvt_pk_bf16_v(O[t][e], 0.f) & 0xffffu);
                __syncthreads();
            }
        }
    }
}

DI void pg_phase(const Args& a, int G, int tid) {
    unsigned char* ws = a.ws; const float* gw = a.in[6];
    bf16* ACT = (bf16*)(ws + WS_ACT); bf16* Ob = ACT + 2 * ACTSZ; const bf16* Zb = ACT + 3 * ACTSZ;
    const size_t total = (size_t)M * 128, stride = (size_t)G * 512;
    const int dv0 = (tid & 15) * 8;
    const f32x4 g0 = *(const f32x4*)(gw + dv0), g1 = *(const f32x4*)(gw + dv0 + 4);
    const float gg[8] = {g0.x, g0.y, g0.z, g0.w, g1.x, g1.y, g1.z, g1.w};
    for (size_t base = (size_t)blockIdx.x * 512 + tid; base < total; base += 8 * stride) {
        v4u ov[8], zv[8];
#pragma unroll
        for (int u = 0; u < 8; ++u) { const size_t idx = base + u * stride; if (idx < total) { const size_t m = idx >> 7; const int cgp = (int)(idx & 127);
            ov[u] = *(const v4u*)(Ob + m * 1024 + cgp * 8); zv[u] = *(const v4u*)(Zb + m * 1024 + cgp * 8); } }
#pragma unroll
        for (int u = 0; u < 8; ++u) { const size_t idx = base + u * stride; if (idx < total) { const size_t m = idx >> 7; const int cgp = (int)(idx & 127);
            float of[8], ss = 0.f;
#pragma unroll
            for (int e = 0; e < 4; ++e) { of[2 * e] = bf_lo(ov[u][e]); of[2 * e + 1] = bf_hi(ov[u][e]); ss += of[2 * e] * of[2 * e] + of[2 * e + 1] * of[2 * e + 1]; }
            ss = row16_sum(ss);
            const float rstd = __builtin_amdgcn_rsqf(ss * (1.f / HD) + EPS);
            v4u o;
#pragma unroll
            for (int e = 0; e < 4; ++e) o[e] = cvt_pk_bf16(of[2 * e] * rstd * gg[2 * e] * bf_lo(zv[u][e]), of[2 * e + 1] * rstd * gg[2 * e + 1] * bf_hi(zv[u][e]));
            *(v4u*)(Ob + m * 1024 + cgp * 8) = o; } }
    }
}

DI void p6_phase(const Args& a, int vcu, int G, int lane, int wave) {
    const float* fw = a.in[10];
    const int gw = vcu * NWAVES + wave, NGW = G * NWAVES;
    f32x4 w[4];
#pragma unroll
    for (int j = 0; j < 4; ++j) w[j] = ((const f32x4*)fw)[lane + 64 * j];
    for (int m = gw; m < M; m += 4 * NGW) {
        f32x4 v[4][4];
#pragma unroll
        for (int u = 0; u < 4; ++u) { const int mm = m + u * NGW; if (mm < M) { const f32x4* yr = (const f32x4*)(a.out + (size_t)mm * D) + lane;
#pragma unroll
            for (int j = 0; j < 4; ++j) v[u][j] = yr[64 * j]; } }
#pragma unroll
        for (int u = 0; u < 4; ++u) { const int mm = m + u * NGW; if (mm < M) { f32x4* yr = (f32x4*)(a.out + (size_t)mm * D) + lane; float s = 0.f;
#pragma unroll
            for (int j = 0; j < 4; ++j) s += (v[u][j].x * v[u][j].x + v[u][j].y * v[u][j].y) + (v[u][j].z * v[u][j].z + v[u][j].w * v[u][j].w);
            const float rstd = 1.f / sqrtf(wave_sum(s) * (1.f / D) + EPS);
#pragma unroll
            for (int j = 0; j < 4; ++j) yr[64 * j] = v[u][j] * rstd * w[j]; } }
    }
}

#ifndef MK_SKIP_GDN
#define MK_SKIP_GDN 0
#endif
__global__ void __launch_bounds__(NWAVES * 64, 2) hybrid_fwd(Args args) {
    extern __shared__ __attribute__((aligned(16))) unsigned char lds_raw[];
    cg::grid_group grid = cg::this_grid();
    LAS unsigned char* lds = (LAS unsigned char*)lds_raw;
    const int tid = threadIdx.x, lane = tid & 63, wave = __builtin_amdgcn_readfirstlane(tid >> 6);
    const int G = gridDim.x, bx = blockIdx.x;
    const int vcu = (G % 8 == 0) ? (bx % 8) * (G / 8) + bx / 8 : bx;
    unsigned char* ws = args.ws;
    bf16* ACT = (bf16*)(ws + WS_ACT);

    volatile LAS unsigned* xst = (volatile LAS unsigned*)(lds + LDS_BYTES - 16);
    if (tid < 4) xst[tid] = 0u;
    __syncthreads();
    XcdBarrier xbar = xcd_barrier_post((unsigned*)ws, xst);
#ifndef NO_P0
    p0_prologue(args, lds, vcu, G, tid, lane, wave);
#endif
    if (bx == 0 && tid < 64) ((unsigned*)(ws + WS_EGL + 32768))[16 * tid] = 0u;
#ifdef PROBE_P0X2
    __syncthreads();
    p0_prologue(args, lds, vcu, G, tid, lane, wave);
#endif
    grid.sync();
    {
        pg8::Gemm g{(const bf16*)(ws + WS_HB), (const bf16*)(ws + WS_WIN), M, N1, D, D, D / 64, 0};
        pg8::StaticOrder S; S.init(M, N1, G, bx);
        pg8::EpiProj E{ACT, (bf16*)(ws + WS_HALO), ACTSZ};
        pg8::gemm_phase<pg8::EpiProj, pg8::StaticOrder, true, true>(lds, g, S, E);
#ifdef PROBE_P1X2
        pg8::gemm_phase<pg8::EpiProj, pg8::StaticOrder, true, true>(lds, g, S, E);
#endif
    }
    xcd_barrier(xbar);
#ifndef NO_PA
    pa_phase(args, lds, G, tid, lane, wave);
#endif
    xcd_barrier(xbar);
#ifndef NO_PB
    pb_phase(args, lds, vcu, G, tid, lane, wave);
#endif
    if (G > 2 * BATCH * NH) { if (bx >= 2 * BATCH * NH) yc_phase(args, 2 * BATCH * NH, G, tid); } else yc_phase(args, 0, G, tid);
    xcd_barrier(xbar);
    pg_phase(args, G, tid);
    xcd_barrier(xbar);
    {
        pg8::Gemm g{ACT + 2 * ACTSZ, (const bf16*)(ws + WS_WOUT), M, D, KMIX, 1024, 16, (long)(3 * ACTSZ * 2)};
        pg8::StaticOrder S; S.init(M, D, G, bx);
        if (G == 256) {
            pg8::EpiResNorm E{args.in[0], args.out, args.in[10], (float*)(ws + WS_SSQ), (unsigned*)(ws + WS_EGL + 32768), D, EPS};
            pg8::gemm_phase<pg8::EpiResNorm, pg8::StaticOrder, false, true>(lds, g, S, E);
        } else {
            pg8::EpiRes E{args.in[0], args.out, D};
            pg8::gemm_phase<pg8::EpiRes, pg8::StaticOrder, true, true>(lds, g, S, E);
            grid.sync();
            p6_phase(args, vcu, G, lane, wave);
        }
    }
}

extern "C" void kernel_launch(void* const* d_in, const int* in_sizes, int n_in, void* d_out, int out_size, void* d_ws, size_t ws_size, hipStream_t stream) {
    static int grid = 0;
    if (grid == 0) {
        if (n_in != 11 || in_sizes[0] != M * D || out_size != M * D || ws_size < WS_END) { fprintf(stderr, "kernel_launch: unexpected shapes (n_in %d, in0 %d, out %d, ws %zu)\n", n_in, n_in > 0 ? in_sizes[0] : -1, out_size, ws_size); grid = -1; return; }
        int dev = 0, cus = 0, per_cu = 0;
        if (hipGetDevice(&dev) != hipSuccess || hipDeviceGetAttribute(&cus, hipDeviceAttributeMultiprocessorCount, dev) != hipSuccess) { grid = -1; return; }
        if (hipFuncSetAttribute((const void*)hybrid_fwd, hipFuncAttributeMaxDynamicSharedMemorySize, LDS_BYTES) != hipSuccess) { fprintf(stderr, "kernel_launch: hipFuncSetAttribute failed\n"); grid = -1; return; }
        if (hipOccupancyMaxActiveBlocksPerMultiprocessor(&per_cu, (const void*)hybrid_fwd, NWAVES * 64, LDS_BYTES) != hipSuccess || per_cu < 1) { fprintf(stderr, "kernel_launch: occupancy query gave %d\n", per_cu); (void)hipGetLastError(); per_cu = 1; }
        grid = cus * 1;
        if (grid > cus * per_cu) grid = cus * per_cu;
    }
    if (grid < 0) return;
    if (hipMemsetAsync(d_ws, 0, 16384, stream) != hipSuccess) { fprintf(stderr, "kernel_launch: memset of the barrier words failed\n"); return; }
    Args a{};
    for (int i = 0; i < 11; ++i) a.in[i] = (const float*)d_in[i];
    a.out = (float*)d_out; a.ws = (unsigned char*)d_ws;
    void* kargs[] = {&a};
    hipError_t e = hipLaunchCooperativeKernel((const void*)hybrid_fwd, dim3(grid), dim3(NWAVES * 64), kargs, LDS_BYTES, stream);
    if (e != hipSuccess) fprintf(stderr, "kernel_launch: cooperative launch failed: %s (grid %d)\n", hipGetErrorString(e), grid);
}
```

```cpp
#include <hip/hip_runtime.h>
#include <hip/hip_cooperative_groups.h>
#include <cstdio>
#include <cstdint>
namespace cg = cooperative_groups;
namespace pg8 {
#define PG8_LAS __attribute__((address_space(3)))
typedef unsigned short bf16_t;
typedef short bf16x8 __attribute__((ext_vector_type(8)));
typedef float f32x4 __attribute__((ext_vector_type(4)));
typedef unsigned u32x4 __attribute__((ext_vector_type(4)));
constexpr int BM = 256, BK = 64, HALF = 128, HTB = HALF * BK * 2  , STAGE_BYTES = 8 * HTB, NXCD = 8, WGM = 8;

__host__ __device__ __forceinline__ int lds_byte(int r, int c) { const int st = (r >> 4) * 2 + (c >> 5), rr = r & 15, cc = c & 31, ob = rr * 64 + cc * 2; return st * 1024 + (ob ^ (((ob >> 9) & 1) << 5)); }
__host__ __device__ __forceinline__ void stage_rc(int b, int& R, int& C) { const int st = b / 1024, sb = b % 1024, swz = sb ^ (((sb >> 9) & 1) << 5); R = (st >> 1) * 16 + swz / 64; C = (st & 1) * 32 + (swz % 64) / 2; }
__host__ __device__ __forceinline__ int perm32(int rho) { const int n = rho >> 4, i = rho & 15; return 8 * (i >> 2) + 4 * n + (i & 3); }

struct Unit { int pm, pn; };
struct Gemm { const bf16_t* A; const bf16_t* Bt; int M, N, K, lda, ksplit; long a2off; };

struct StaticOrder {
    int nM, nN, nwg, G, c;
    __host__ __device__ void init(int M, int N, int G_, int c_) { nM = M / BM; nN = N / BM; nwg = nM * nN; G = G_; c = c_; }
    __host__ __device__ bool next(int i, Unit& u) const {
        const long L = (long)i * G + c; if (L >= nwg) return false;
        int wgid = (int)L; { const int q = nwg / NXCD, r = nwg % NXCD, xcd = wgid % NXCD, off = wgid / NXCD; wgid = (xcd < r ? xcd * (q + 1) : r * (q + 1) + (xcd - r) * q) + off; }
        const int nig = WGM * nN, gid = wgid / nig, fm = gid * WGM, gsz = (nM - fm) < WGM ? (nM - fm) : WGM;
        u.pm = fm + ((wgid % nig) % gsz); u.pn = (wgid % nig) / gsz; return true;
    }
    __device__ __forceinline__ void a_ready(const Unit&) const {}
    __device__ __forceinline__ void done(const Unit&) const {}
};


typedef float f32x2_cv __attribute__((ext_vector_type(2)));
typedef __bf16 bf16x2_cv __attribute__((ext_vector_type(2)));
__device__ __forceinline__ unsigned cvt_pk_bf16_v(float lo, float hi) { f32x2_cv v = {lo, hi}; bf16x2_cv r = __builtin_convertvector(v, bf16x2_cv); return __builtin_bit_cast(unsigned, r); }
__device__ __forceinline__ unsigned cvt_pk_bf16(float lo, float hi) { unsigned r; asm volatile("v_cvt_pk_bf16_f32 %0, %1, %2" : "=v"(r) : "v"(lo), "v"(hi)); return r; }
__device__ __forceinline__ float silu_f(float x) { return x * __builtin_amdgcn_rcpf(1.f + __expf(-x)); }

struct EpiProj {
    static constexpr bool PERM = true, AFTER_DRAIN = false;
    bf16_t* ACT; bf16_t* HALO; size_t actsz;
    __device__ __forceinline__ void operator()(const f32x4 (&acc)[2][2][4][2], const Unit& u, int wr, int wc, int fr, int fq) const {
        const int pn = u.pn, row0 = u.pm * BM + wr * 64 + fr, cw = wc * 32 + 8 * fq;
        if (pn < 16) {
            bf16_t* base = ACT + (size_t)(pn >> 2) * actsz + (pn & 3) * 256 + cw;
            const bool act = pn >= 12, halo = pn < 12;
#pragma unroll
            for (int ai = 0; ai < 2; ++ai)
#pragma unroll
                for (int m = 0; m < 4; ++m) { const int row = row0 + ai * HALF + m * 16; bf16_t* rowp = base + (size_t)row * 1024;
#pragma unroll
                    for (int bj = 0; bj < 2; ++bj) { f32x4 v0 = acc[ai][bj][m][0], v1 = acc[ai][bj][m][1];
                        if (act) {
#pragma unroll
                            for (int j = 0; j < 4; ++j) { v0[j] = silu_f(v0[j]); v1[j] = silu_f(v1[j]); } }
                        u32x4 w; w.x = cvt_pk_bf16_v(v0[0], v0[1]); w.y = cvt_pk_bf16_v(v0[2], v0[3]); w.z = cvt_pk_bf16_v(v1[0], v1[1]); w.w = cvt_pk_bf16_v(v1[2], v1[3]);
                        *(u32x4*)(rowp + bj * HALF) = w;
                        if (m == 3 && halo && fr >= 13) *(u32x4*)(HALO + ((size_t)(row >> 6) * 3 + (fr - 13)) * 3072 + pn * 256 + bj * HALF + cw) = w; } }
        } else {
            const bool kind = pn >= 24; bf16_t* base = ACT + (size_t)(kind ? 5 : 4) * actsz + ((pn - 16) & 7) * 128 + cw;
#pragma unroll
            for (int ai = 0; ai < 2; ++ai)
#pragma unroll
                for (int m = 0; m < 4; ++m) { const int row = row0 + ai * HALF + m * 16;
                    f32x4 a0 = acc[ai][0][m][0], a1 = acc[ai][0][m][1], b0 = acc[ai][1][m][0], b1 = acc[ai][1][m][1];
                    if (kind) {
#pragma unroll
                        for (int j = 0; j < 4; ++j) { b0[j] = silu_f(b0[j]); b1[j] = silu_f(b1[j]); } }
                    a0 = a0 * b0; a1 = a1 * b1;
                    u32x4 w; w.x = cvt_pk_bf16(a0[0], a0[1]); w.y = cvt_pk_bf16(a0[2], a0[3]); w.z = cvt_pk_bf16(a1[0], a1[1]); w.w = cvt_pk_bf16(a1[2], a1[3]);
                    *(u32x4*)(base + (size_t)row * 1024) = w; }
        }
    }
};
struct EpiResNorm {
    static constexpr bool PERM = false, AFTER_DRAIN = true;
    const float* X; float* Y; const float* FW; float* part; unsigned* cnt; int ldc; float eps;
    __device__ __forceinline__ void operator()(const f32x4 (&)[2][2][4][2], const Unit&, int, int, int, int) const {}
    __device__ __forceinline__ void fused(const f32x4 (&acc)[2][2][4][2], const Unit& u, int wr, int wc, int fr, int fq, PG8_LAS unsigned char* lds, int wid, int lane) const {
        PG8_LAS float* red = (PG8_LAS float*)lds;
        PG8_LAS float* rs = (PG8_LAS float*)(lds + 4096);
        const int row0 = u.pm * BM + wr * 64 + fr, col0 = u.pn * BM + wc * 32 + 4 * fq; int tid = threadIdx.x; asm volatile("" : "+v"(tid));
#pragma unroll
        for (int ai = 0; ai < 2; ++ai)
#pragma unroll
            for (int m = 0; m < 4; ++m) { const size_t o = (size_t)(row0 + ai * HALF + m * 16) * ldc + col0; float ss = 0.f;
#pragma unroll
                for (int bj = 0; bj < 2; ++bj)
#pragma unroll
                    for (int n = 0; n < 2; ++n) { const f32x4 y = acc[ai][bj][m][n] + *(const f32x4*)(X + o + bj * HALF + n * 16); ss += (y.x * y.x + y.y * y.y) + (y.z * y.z + y.w * y.w); }
                ss += __shfl_xor(ss, 16); ss += __shfl_xor(ss, 32);
                if (fq == 0) red[((wr * 4 + wc) * 8 + ai * 4 + m) * 16 + fr] = ss; }
        __syncthreads();
        if (tid < 256) { const int w_ = (tid >> 6) & 1, ai = tid >> 7, m = (tid >> 4) & 3, f = tid & 15; float s = 0.f;
#pragma unroll
            for (int c = 0; c < 4; ++c) s += red[((w_ * 4 + c) * 8 + ai * 4 + m) * 16 + f];
            __hip_atomic_store(part + (size_t)(u.pm * BM + tid) * 4 + u.pn, s, __ATOMIC_RELAXED, __HIP_MEMORY_SCOPE_AGENT); }
        asm volatile("s_waitcnt vmcnt(0)" ::: "memory");
        __syncthreads();
        if (tid == 0) { __hip_atomic_fetch_add(cnt + 16 * u.pm, 1u, __ATOMIC_RELAXED, __HIP_MEMORY_SCOPE_AGENT);
            while (__hip_atomic_load(cnt + 16 * u.pm, __ATOMIC_RELAXED, __HIP_MEMORY_SCOPE_AGENT) < 4u) __builtin_amdgcn_s_sleep(2); }
        __syncthreads();
        if (tid < 256) { const float* pp = part + (size_t)(u.pm * BM + tid) * 4; float s = 0.f;
#pragma unroll
            for (int c = 0; c < 4; ++c) s += __hip_atomic_load(pp + c, __ATOMIC_RELAXED, __HIP_MEMORY_SCOPE_AGENT);
            rs[tid] = 1.f / sqrtf(s * (1.f / 1024.f) + eps); }
        __syncthreads();
        f32x4 fw[2][2];
#pragma unroll
        for (int bj = 0; bj < 2; ++bj)
#pragma unroll
            for (int n = 0; n < 2; ++n) fw[bj][n] = *(const f32x4*)(FW + col0 + bj * HALF + n * 16);
#pragma unroll
        for (int ai = 0; ai < 2; ++ai)
#pragma unroll
            for (int m = 0; m < 4; ++m) { const size_t o = (size_t)(row0 + ai * HALF + m * 16) * ldc + col0; const float rstd = rs[ai * HALF + wr * 64 + m * 16 + fr];
#pragma unroll
                for (int bj = 0; bj < 2; ++bj)
#pragma unroll
                    for (int n = 0; n < 2; ++n) { const f32x4 y = acc[ai][bj][m][n] + *(const f32x4*)(X + o + bj * HALF + n * 16); *(f32x4*)(Y + o + bj * HALF + n * 16) = y * rstd * fw[bj][n]; } }
    }
};
struct EpiRes {
    static constexpr bool PERM = false, AFTER_DRAIN = false;
    const float* X; float* Y; int ldc;
    __device__ __forceinline__ void operator()(const f32x4 (&acc)[2][2][4][2], const Unit& u, int wr, int wc, int fr, int fq) const {
        const int row0 = u.pm * BM + wr * 64 + fr, col0 = u.pn * BM + wc * 32 + 4 * fq;
#pragma unroll
        for (int ai = 0; ai < 2; ++ai)
#pragma unroll
            for (int m = 0; m < 4; ++m) { const size_t o = (size_t)(row0 + ai * HALF + m * 16) * ldc + col0;
#pragma unroll
                for (int bj = 0; bj < 2; ++bj)
#pragma unroll
                    for (int n = 0; n < 2; ++n) *(f32x4*)(Y + o + bj * HALF + n * 16) = acc[ai][bj][m][n] + *(const f32x4*)(X + o + bj * HALF + n * 16); }
    }
};

template <class Epi, class Sched, bool ALIGN_EPI = false, bool SP2 = false>
__device__ __forceinline__ void gemm_phase(PG8_LAS unsigned char* lds, const Gemm g, const Sched& S, const Epi& E) {
    const int tid = threadIdx.x, wid = __builtin_amdgcn_readfirstlane(tid >> 6), lane = tid & 63, wr = wid >> 2, wc = wid & 3, fr = lane & 15, fq = lane >> 4;
    const int K = g.K, nt = K / BK, lda = g.lda, ksplit = g.ksplit; const long a2off = g.a2off;
    unsigned voffA[2], voffB[2];
#pragma unroll
    for (int i = 0; i < 2; ++i) { int R, C; stage_rc(tid * 16 + i * 8192, R, C); const int Rb = Epi::PERM ? ((R & ~31) + perm32(R & 31)) : R;
        voffA[i] = (unsigned)(R * lda + C) * 2u; voffB[i] = (unsigned)(Rb * K + C) * 2u; }
    const size_t kstep = (size_t)(BK * 2);
    const size_t hstep = (size_t)HALF * K * 2;
    const size_t tstep = 2 * hstep; const size_t hstepA = (size_t)HALF * lda * 2, tstepA = 2 * hstepA;
#define PG8_AK(base, t) ((base) + (((t) < ksplit) ? (long)(t) * (long)kstep : a2off + (long)((t) - ksplit) * (long)kstep))
    const unsigned ldsw = (unsigned)wid * 1024u;
    const int aoff = lds_byte(wr * 64 + fr, fq * 8), boff = lds_byte(wc * 32 + fr, fq * 8);
#define PG8_SA(b, h) (((b) * 2 + (h)) * HTB)
#define PG8_SB(b, h) ((4 + (b) * 2 + (h)) * HTB)
#define PG8_STAGE(bufoff, gbase, voff) do { _Pragma("unroll") for (int _i = 0; _i < 2; ++_i) \
        __builtin_amdgcn_global_load_lds((const unsigned*)((const char*)(gbase) + (voff)[_i]), (PG8_LAS unsigned*)(lds + (bufoff) + ldsw + _i * 8192), 16, 0, 0); } while (0)
#define PG8_LDA(dst, b, h) do { _Pragma("unroll") for (int m = 0; m < 4; ++m) _Pragma("unroll") for (int k = 0; k < 2; ++k) dst[m][k] = *(const PG8_LAS bf16x8*)(lds + PG8_SA(b, h) + aoff + m * 2048 + k * 1024); } while (0)
#define PG8_LDB(dst, b, h) do { _Pragma("unroll") for (int n = 0; n < 2; ++n) _Pragma("unroll") for (int k = 0; k < 2; ++k) dst[n][k] = *(const PG8_LAS bf16x8*)(lds + PG8_SB(b, h) + boff + n * 2048 + k * 1024); } while (0)
#define PG8_MMA(ai, bj, At, Bt) do { __builtin_amdgcn_s_setprio(1); _Pragma("unroll") for (int m = 0; m < 4; ++m) _Pragma("unroll") for (int n = 0; n < 2; ++n) _Pragma("unroll") for (int k = 0; k < 2; ++k) \
        acc[ai][bj][m][n] = __builtin_amdgcn_mfma_f32_16x16x32_bf16(Bt[n][k], At[m][k], acc[ai][bj][m][n], 0, 0, 0); __builtin_amdgcn_s_setprio(0); } while (0)
#define PG8_WAIT_V(n) asm volatile("s_waitcnt vmcnt(" #n ")" ::: "memory")
#define PG8_WAIT_L(n) asm volatile("s_waitcnt lgkmcnt(" #n ")" ::: "memory")
#define PG8_BAR __builtin_amdgcn_s_barrier()
#define PG8_SCHED __builtin_amdgcn_sched_barrier(0)
    Unit cur, nxt; int ui = 0;
    if (!S.next(0, cur)) return;
    f32x4 acc[2][2][4][2];
#pragma unroll
    for (int a = 0; a < 2; ++a)
#pragma unroll
        for (int b = 0; b < 2; ++b)
#pragma unroll
            for (int m = 0; m < 4; ++m)
#pragma unroll
                for (int n = 0; n < 2; ++n) acc[a][b][m][n] = (f32x4){0.f, 0.f, 0.f, 0.f};
    bf16x8 At[4][2], B0[2][2], B1[2][2];
    const char* cA = (const char*)g.A + (size_t)cur.pm * tstepA; const char* cB = (const char*)g.Bt + (size_t)cur.pn * tstep;
    S.a_ready(cur);
    if constexpr (SP2) {
        PG8_STAGE(PG8_SB(0, 0), cB, voffB); PG8_STAGE(PG8_SB(0, 1), cB + hstep, voffB); PG8_STAGE(PG8_SA(0, 0), cA, voffA); PG8_STAGE(PG8_SA(0, 1), cA + hstepA, voffA);
        if (wr == 1) PG8_BAR;
        PG8_WAIT_V(2); PG8_BAR;
        PG8_STAGE(PG8_SB(1, 0), cB + kstep, voffB); PG8_STAGE(PG8_SA(1, 0), cA + kstep, voffA); PG8_STAGE(PG8_SB(1, 1), cB + hstep + kstep, voffB);
        PG8_WAIT_V(6); PG8_BAR;
    } else {
        PG8_STAGE(PG8_SB(0, 0), cB, voffB); PG8_STAGE(PG8_SA(0, 0), cA, voffA); PG8_STAGE(PG8_SB(0, 1), cB + hstep, voffB); PG8_STAGE(PG8_SA(0, 1), cA + hstepA, voffA);
        if (wr == 1) PG8_BAR;
        PG8_WAIT_V(4); PG8_BAR;
        PG8_STAGE(PG8_SB(1, 0), cB + kstep, voffB); PG8_STAGE(PG8_SA(1, 0), cA + kstep, voffA); PG8_STAGE(PG8_SB(1, 1), cB + hstep + kstep, voffB);
        PG8_WAIT_V(6); PG8_BAR;
    }
    for (;;) {
        const bool has_next = S.next(ui + 1, nxt);
        const char* nA = has_next ? (const char*)g.A + (size_t)nxt.pm * tstepA : cA; const char* nB = has_next ? (const char*)g.Bt + (size_t)nxt.pn * tstep : cB;
        for (int t = 0; t < nt; t += 2) {
            const bool last = (t == nt - 2);
            const char* a1 = PG8_AK(cA, t + 1);
            const char* a2 = last ? nA : PG8_AK(cA, t + 2); const char* b2 = last ? nB : cB + (size_t)(t + 2) * kstep;
            const char* a3 = last ? nA + kstep : PG8_AK(cA, t + 3); const char* b3 = b2 + kstep;
            if (last && has_next) S.a_ready(nxt);
            if constexpr (SP2) {
            PG8_LDB(B0, 0, 0); PG8_LDB(B1, 0, 1); PG8_SCHED; PG8_LDA(At, 0, 0); PG8_STAGE(PG8_SA(1, 1), a1 + hstepA, voffA);
            PG8_WAIT_V(8); PG8_WAIT_L(0); PG8_BAR; PG8_MMA(0, 0, At, B0); PG8_MMA(0, 1, At, B1); PG8_BAR; PG8_SCHED;
            PG8_LDA(At, 0, 1); PG8_STAGE(PG8_SB(0, 0), b2, voffB); PG8_STAGE(PG8_SB(0, 1), b2 + hstep, voffB); PG8_STAGE(PG8_SA(0, 0), a2, voffA);
            PG8_WAIT_V(8); PG8_WAIT_L(0); PG8_BAR; PG8_MMA(1, 0, At, B0); PG8_MMA(1, 1, At, B1); PG8_BAR; PG8_SCHED;
            PG8_LDB(B0, 1, 0); PG8_LDB(B1, 1, 1); PG8_SCHED; PG8_LDA(At, 1, 0); PG8_STAGE(PG8_SA(0, 1), a2 + hstepA, voffA);
            PG8_WAIT_V(8); PG8_WAIT_L(0); PG8_BAR; PG8_MMA(0, 0, At, B0); PG8_MMA(0, 1, At, B1); PG8_BAR; PG8_SCHED;
            PG8_LDA(At, 1, 1); PG8_STAGE(PG8_SB(1, 0), b3, voffB); PG8_STAGE(PG8_SB(1, 1), b3 + hstep, voffB); PG8_STAGE(PG8_SA(1, 0), a3, voffA);
            PG8_WAIT_V(8); PG8_WAIT_L(0); PG8_BAR; PG8_MMA(1, 0, At, B0); PG8_MMA(1, 1, At, B1); PG8_BAR; PG8_SCHED;
            } else {
            PG8_LDB(B0, 0, 0); PG8_SCHED; PG8_LDA(At, 0, 0); PG8_STAGE(PG8_SA(1, 1), a1 + hstepA, voffA);
            PG8_WAIT_L(8); PG8_BAR; PG8_WAIT_L(0); PG8_MMA(0, 0, At, B0); PG8_BAR; PG8_SCHED;
            PG8_LDB(B1, 0, 1); PG8_STAGE(PG8_SB(0, 0), b2, voffB);
            PG8_BAR; PG8_WAIT_L(0); PG8_MMA(0, 1, At, B1); PG8_BAR;
            PG8_LDA(At, 0, 1); PG8_STAGE(PG8_SA(0, 0), a2, voffA);
            PG8_BAR; PG8_WAIT_L(0); PG8_MMA(1, 0, At, B0); PG8_BAR; PG8_SCHED;
            PG8_STAGE(PG8_SB(0, 1), b2 + hstep, voffB);
            PG8_WAIT_V(6); PG8_BAR; PG8_MMA(1, 1, At, B1); PG8_BAR;
            PG8_LDB(B0, 1, 0); PG8_SCHED; PG8_LDA(At, 1, 0); PG8_STAGE(PG8_SA(0, 1), a2 + hstepA, voffA);
            PG8_WAIT_L(8); PG8_BAR; PG8_WAIT_L(0); PG8_MMA(0, 0, At, B0); PG8_BAR; PG8_SCHED;
            PG8_LDB(B1, 1, 1); PG8_STAGE(PG8_SB(1, 0), b3, voffB);
            PG8_BAR; PG8_WAIT_L(0); PG8_MMA(0, 1, At, B1); PG8_BAR;
            PG8_LDA(At, 1, 1); PG8_STAGE(PG8_SA(1, 0), a3, voffA);
            PG8_BAR; PG8_WAIT_L(0); PG8_MMA(1, 0, At, B0); PG8_BAR; PG8_SCHED;
            PG8_STAGE(PG8_SB(1, 1), b3 + hstep, voffB);
            PG8_WAIT_V(6); PG8_BAR; PG8_MMA(1, 1, At, B1); PG8_BAR;
            }
        }
        if constexpr (ALIGN_EPI) { if (wr == 0) PG8_BAR; }
        if constexpr (!Epi::AFTER_DRAIN) { E(acc, cur, wr, wc, fr, fq); S.done(cur); }
        if (!has_next) break;
#pragma unroll
        for (int a = 0; a < 2; ++a)
#pragma unroll
            for (int b = 0; b < 2; ++b)
#pragma unroll
                for (int m = 0; m < 4; ++m)
#pragma unroll
                    for (int n = 0; n < 2; ++n) acc[a][b][m][n] = (f32x4){0.f, 0.f, 0.f, 0.f};
        cur = nxt; cA = nA; cB = nB; ++ui;
        if constexpr (ALIGN_EPI) { if (wr == 1) PG8_BAR; }
    }
    PG8_WAIT_V(0);
    if constexpr (!ALIGN_EPI) { if (wr == 0) PG8_BAR; }
    PG8_BAR;
    if constexpr (Epi::AFTER_DRAIN) { E.fused(acc, cur, wr, wc, fr, fq, lds, wid, lane); S.done(cur); }
#undef PG8_AK
#undef PG8_SA
#undef PG8_SB
#undef PG8_STAGE
#undef PG8_LDA
#undef PG8_LDB
#undef PG8_MMA
#undef PG8_WAIT_V
#undef PG8_WAIT_L
#undef PG8_BAR
#undef PG8_SCHED
}
}


constexpr int BATCH = 8, T = 2048, D = 1024, M = BATCH * T, NH = 8, HD = 128, PW = 8208, N1 = 8192, KMIX = 2048, CH = 64, NCH = T / CH;
constexpr int NITEM = BATCH * NCH * NH;
constexpr float EPS = 1e-6f;
constexpr int NWAVES = 8;
constexpr size_t MiB = 1u << 20;
constexpr size_t WS_WIN = 1 * MiB;
constexpr size_t WS_WOUT = 17 * MiB;
constexpr size_t WS_G = 21 * MiB;
constexpr size_t WS_BETA = WS_G + 512 * 1024;
constexpr size_t WS_HALO = 22 * MiB;
constexpr size_t WS_EGL = 27 * MiB;
constexpr size_t WS_SSQ = 28 * MiB;
constexpr size_t WS_HB = 32 * MiB;
constexpr size_t WS_ACT = 64 * MiB;
constexpr size_t ACTSZ = (size_t)M * 1024;
constexpr size_t WS_END = 256 * MiB;
static_assert(WS_ACT + 6 * ACTSZ * 2 == WS_END, "ws map");
constexpr int LDS_BYTES = 147456;

#define LAS __attribute__((address_space(3)))
#define DI __device__ __forceinline__
typedef unsigned short bf16;
typedef unsigned v4u __attribute__((ext_vector_type(4)));
typedef unsigned v2u __attribute__((ext_vector_type(2)));
typedef float f32x4 __attribute__((ext_vector_type(4)));
typedef float f32x2 __attribute__((ext_vector_type(2)));
typedef short bf16x8 __attribute__((ext_vector_type(8)));
using pg8::cvt_pk_bf16;
using pg8::cvt_pk_bf16_v;
using pg8::silu_f;
DI float bf_lo(unsigned u) { return __uint_as_float(u << 16); }
DI float bf_hi(unsigned u) { return __uint_as_float(u & 0xffff0000u); }
#define DPP_MOV(x, ctrl) __int_as_float(__builtin_amdgcn_mov_dpp(__float_as_int(x), (ctrl), 0xF, 0xF, true))
#define DPP_UPD0(x, ctrl, rmask) __int_as_float(__builtin_amdgcn_update_dpp(0, __float_as_int(x), (ctrl), (rmask), 0xF, false))
DI float row16_sum(float v) { v += DPP_MOV(v, 0xB1); v += DPP_MOV(v, 0x4E); v += DPP_MOV(v, 0x141); v += DPP_MOV(v, 0x140); return v; }
DI float wave_sum(float v) {
    v = row16_sum(v);
    v += DPP_UPD0(v, 0x142, 0xA);
    v += DPP_UPD0(v, 0x143, 0xC);
    return __int_as_float(__builtin_amdgcn_readlane(__float_as_int(v), 63));
}
DI int posf(int idx) { return (idx & ~31) | (((idx >> 2) & 3) << 3) | (((idx >> 4) & 1) << 2) | (idx & 3); }
constexpr int permf(int p) { return (p & ~31) | (((p >> 2) & 1) << 4) | (((p >> 3) & 3) << 2) | (p & 3); }
#define LDSV(T, name, src) unsigned name##_u = (unsigned)(size_t)(src); asm volatile("" : "+v"(name##_u)); T name = (T)name##_u
#ifndef DBG_NO_HALO
#define DBG_NO_HALO 0
#endif
#define MFMA16(a, b, c) __builtin_amdgcn_mfma_f32_16x16x32_bf16((a), (b), (c), 0, 0, 0)

struct Args { const float* in[11]; float* out; unsigned char* ws; };

#define XB_TMO      128
#define XB_XCNT(j)  (256  + 64 * (j))
#define XB_XSUB(j)  (1280 + 64 * (j))
#define XB_XGEN(j)  (2304 + 64 * (j))
#define XB_TOP      3328
#define XB_TOPGEN   3392
#define XCD_BAR_WORDS 3456
#define XB_SPIN_CAP (1u << 18)

__device__ __forceinline__ unsigned xb_ld(unsigned* p)              { return __hip_atomic_load(p, __ATOMIC_RELAXED, __HIP_MEMORY_SCOPE_AGENT); }
__device__ __forceinline__ unsigned xb_add(unsigned* p, unsigned v) { return __hip_atomic_fetch_add(p, v, __ATOMIC_RELAXED, __HIP_MEMORY_SCOPE_AGENT); }
__device__ __forceinline__ unsigned xb_xcc_id() { return (unsigned)__builtin_amdgcn_s_getreg((3 << 11) | 20) & 0xFu; }
#define XB_SPIN(cond, bar) do { unsigned _sp = 0; while (cond) { __builtin_amdgcn_s_sleep(1); \
    if ((++_sp & 255u) == 0u) { if (xb_ld(&(bar)[XB_TMO])) break; if (_sp > XB_SPIN_CAP) { atomicAdd(&(bar)[XB_TMO], 1u); break; } } } } while (0)

struct XcdBarrier {
    unsigned* bar; unsigned x;
    volatile LAS unsigned* st;
};

__device__ __forceinline__ XcdBarrier xcd_barrier_post(unsigned* bar, volatile LAS unsigned* st) {
    XcdBarrier b; b.bar = bar; b.x = xb_xcc_id(); b.st = st;
    if (threadIdx.x == 0) (void)xb_add(&bar[XB_XCNT(b.x)], 1u);
    return b;
}
__device__ __forceinline__ void xcd_barrier_complete(unsigned* bar, unsigned x, unsigned& nloc, unsigned& nx) {
    const unsigned G = gridDim.x * gridDim.y * gridDim.z;
    unsigned sum, cnt, mine, sp = 0u;
    for (;;) {
        sum = 0u; cnt = 0u; mine = 0u;
#pragma unroll
        for (unsigned j = 0; j < 16; ++j) { const unsigned c = xb_ld(&bar[XB_XCNT(j)]); sum += c; cnt += (c > 0u) ? 1u : 0u; mine = (j == x) ? c : mine; }
        if (sum == G) break;
        __builtin_amdgcn_s_sleep(1);
        if ((++sp & 255u) == 0u) { if (xb_ld(&bar[XB_TMO])) break; if (sp > XB_SPIN_CAP) { atomicAdd(&bar[XB_TMO], 1u); break; } }
    }
    nloc = mine > 0u ? mine : 1u; nx = cnt > 0u ? cnt : 1u;
}

__device__ __forceinline__ void xcd_barrier(const XcdBarrier& b) {
    asm volatile("s_waitcnt vmcnt(0)" ::: "memory");
    __syncthreads();
    if (threadIdx.x == 0) {
        unsigned* bar = b.bar;
        __builtin_amdgcn_s_waitcnt(0);
        unsigned nloc = b.st[0], nx = b.st[1];
        if (nloc == 0u) { xcd_barrier_complete(bar, b.x, nloc, nx); b.st[0] = nloc; b.st[1] = nx; }
        const unsigned old = xb_add(&bar[XB_XSUB(b.x)], 1u);
        const unsigned gen = old / nloc;
        if (old + 1u == (gen + 1u) * nloc) {
            __builtin_amdgcn_fence(__ATOMIC_RELEASE, "agent");
            asm volatile("s_waitcnt vmcnt(0)" ::: "memory");
            const unsigned og = xb_add(&bar[XB_TOP], 1u);
            const unsigned tg = og / nx;
            if (og + 1u == (tg + 1u) * nx) xb_add(&bar[XB_TOPGEN], 1u);
            else XB_SPIN(xb_ld(&bar[XB_TOPGEN]) == tg, bar);
            __builtin_amdgcn_fence(__ATOMIC_ACQUIRE, "agent");
            xb_add(&bar[XB_XGEN(b.x)], 1u);
            asm volatile("s_waitcnt vmcnt(0)" ::: "memory");
        } else {
            XB_SPIN(xb_ld(&bar[XB_XGEN(b.x)]) == gen, bar);
            __builtin_amdgcn_fence(__ATOMIC_ACQUIRE, "agent");
            asm volatile("s_waitcnt vmcnt(0)" ::: "memory");
        }
    }
    __syncthreads();
}


DI int srccol(int n0) {
    if (n0 < 4096) return n0;
    if (n0 < 6144) { const int r = n0 - 4096, tau = r >> 8, w = r & 255; return w < 128 ? 5136 + 128 * tau + w : 6160 + 128 * tau + (w - 128); }
    const int r = n0 - 6144, tau = r >> 8, w = r & 255; return w < 128 ? 4112 + 128 * tau + w : 7184 + 128 * tau + (w - 128);
}
DI void transpose_item(const float* W, int ldw, int srccol0, bf16* WT, int K, int n0, int k0, LAS float* scr, int lane) {
    f32x4 ld[8];
#pragma unroll
    for (int i = 0; i < 8; ++i) { const int pc = lane + 64 * i, kk = pc >> 3, n4 = pc & 7; ld[i] = *(const f32x4*)(W + (size_t)(k0 + kk) * ldw + srccol0 + 4 * n4); }
#pragma unroll
    for (int i = 0; i < 8; ++i) { const int pc = lane + 64 * i, kk = pc >> 3, n4 = pc & 7; LAS float* d = scr + kk * 33 + 4 * n4; d[0] = ld[i].x; d[1] = ld[i].y; d[2] = ld[i].z; d[3] = ld[i].w; }
    asm volatile("s_waitcnt lgkmcnt(0)" ::: "memory");
    const int c = lane & 7;
#pragma unroll
    for (int j = 0; j < 4; ++j) { const int n = (lane >> 3) + 8 * j; const LAS float* s = scr + (8 * c) * 33 + n;
        v4u o; o.x = cvt_pk_bf16(s[0 * 33], s[1 * 33]); o.y = cvt_pk_bf16(s[2 * 33], s[3 * 33]); o.z = cvt_pk_bf16(s[4 * 33], s[5 * 33]); o.w = cvt_pk_bf16(s[6 * 33], s[7 * 33]);
        *(v4u*)(WT + (size_t)(n0 + n) * K + k0 + 8 * c) = o; }
    asm volatile("s_waitcnt lgkmcnt(0)" ::: "memory");
}
DI void p0_prologue(const Args& a, LAS unsigned char* lds, int vcu, int G, int tid, int lane, int wave) {
    unsigned char* ws = a.ws;
    const float* x = a.in[0]; const float* norm_w = a.in[1]; const float* w_in = a.in[2]; const float* A_log = a.in[4]; const float* dt_bias = a.in[5]; const float* w_out = a.in[9];
    bf16* WinT = (bf16*)(ws + WS_WIN); bf16* WoutT = (bf16*)(ws + WS_WOUT); bf16* HB = (bf16*)(ws + WS_HB);
    float* Gb = (float*)(ws + WS_G); float* Bb = (float*)(ws + WS_BETA);
    LAS float* scr = (LAS float*)(lds + wave * 16384);
    const int gw = vcu * NWAVES + wave, NGW = G * NWAVES;
    constexpr int I_IN = (D / 64) * (N1 / 32), I_OUT = (KMIX / 64) * (D / 32);
#define P0_LOAD(dst, mb) do { _Pragma("unroll") for (int u = 0; u < 4; ++u) { const f32x4* xr_ = (const f32x4*)(x + (size_t)min((mb) + u * NGW, M - 1) * D) + lane; \
        _Pragma("unroll") for (int j = 0; j < 4; ++j) dst[u][j] = xr_[64 * j]; } } while (0)
    f32x4 vv[4][4], vnx[4][4];
    P0_LOAD(vv, gw);
    for (int it = gw; it < I_IN + I_OUT; it += NGW) {
        if (it < I_IN) { const int kb = it / (N1 / 32), nb = it % (N1 / 32); transpose_item(w_in, PW, srccol(32 * nb), WinT, D, 32 * nb, 64 * kb, scr, lane); }
        else { const int r = it - I_IN, kb = r / (D / 32), nb = r % (D / 32); transpose_item(w_out, D, 32 * nb, WoutT, KMIX, 32 * nb, 64 * kb, scr, lane); }
    }
    __syncthreads();
    LAS float* wbg = (LAS float*)lds;
    {   float tmpw[32];
#pragma unroll
        for (int i = 0; i < 32; ++i) { const int idx = tid + 512 * i, k = idx >> 4, c = idx & 15; tmpw[i] = w_in[(size_t)k * PW + 4096 + c]; }
#pragma unroll
        for (int i = 0; i < 32; ++i) { const int idx = tid + 512 * i, k = idx >> 4, c = idx & 15; wbg[c * 1024 + k] = tmpw[i]; } }
    __syncthreads();
    const LAS f32x4* wb4 = (const LAS f32x4*)wbg;
    f32x4 nw[4];
#pragma unroll
    for (int j = 0; j < 4; ++j) nw[j] = ((const f32x4*)norm_w)[lane + 64 * j];
    for (int m0 = gw; m0 < M; m0 += 4 * NGW) {
        int mr[4];
#pragma unroll
        for (int u = 0; u < 4; ++u) mr[u] = min(m0 + u * NGW, M - 1);
        if (m0 + 4 * NGW < M) P0_LOAD(vnx, m0 + 4 * NGW);
#pragma unroll
        for (int u = 0; u < 4; ++u) { float s = 0.f;
#pragma unroll
            for (int j = 0; j < 4; ++j) s += (vv[u][j].x * vv[u][j].x + vv[u][j].y * vv[u][j].y) + (vv[u][j].z * vv[u][j].z + vv[u][j].w * vv[u][j].w);
            const float rstd = __builtin_amdgcn_rsqf(wave_sum(s) * (1.f / D) + EPS);
            unsigned long long* o8 = (unsigned long long*)(HB + (size_t)mr[u] * D) + lane;
#pragma unroll
            for (int j = 0; j < 4; ++j) { vv[u][j] = vv[u][j] * rstd * nw[j];
                o8[64 * j] = (unsigned long long)cvt_pk_bf16(vv[u][j].x, vv[u][j].y) | ((unsigned long long)cvt_pk_bf16(vv[u][j].z, vv[u][j].w) << 32); } }
        float ds[64];
#pragma unroll
        for (int c = 0; c < 16; ++c) { f32x2 d2[4] = {{0.f, 0.f}, {0.f, 0.f}, {0.f, 0.f}, {0.f, 0.f}};
#pragma unroll
            for (int j = 0; j < 4; ++j) { const f32x4 w = wb4[c * 256 + lane + 64 * j]; const f32x2 w01 = {w.x, w.y}, w23 = {w.z, w.w};
#pragma unroll
                for (int u = 0; u < 4; ++u) { d2[u] = d2[u] + (f32x2){vv[u][j].x, vv[u][j].y} * w01; d2[u] = d2[u] + (f32x2){vv[u][j].z, vv[u][j].w} * w23; } }
#pragma unroll
            for (int u = 0; u < 4; ++u) ds[16 * u + c] = d2[u].x + d2[u].y; }
#pragma unroll
        for (int o = 32; o >= 1; o >>= 1) { const bool up = (lane & o) != 0;
#pragma unroll
            for (int k = 0; k < o; ++k) { const float lo = ds[k], hi = ds[k + o]; const float send = up ? lo : hi, keep = up ? hi : lo; ds[k] = keep + __shfl_xor(send, o); } }
        {   const float sel = ds[0]; const int u = lane >> 4, c = lane & 15; const int m = (u == 0) ? mr[0] : (u == 1 ? mr[1] : (u == 2 ? mr[2] : mr[3]));
            if (c < 8) Bb[(size_t)m * 8 + c] = 1.f / (1.f + expf(-sel));
            else { const int h = c - 8; const float xx = sel + dt_bias[h]; const float sp = fmaxf(xx, 0.f) + log1pf(expf(-fabsf(xx))); Gb[(size_t)m * 8 + h] = -expf(A_log[h]) * sp; } }
#pragma unroll
        for (int u = 0; u < 4; ++u)
#pragma unroll
            for (int j = 0; j < 4; ++j) vv[u][j] = vnx[u][j];
    }
#undef P0_LOAD
}

constexpr int KN_STRIDE = 136;
constexpr int AT_STRIDE = 68;
constexpr int PA_KN = 0, PA_QN = 64 * KN_STRIDE * 2, PA_AT = 2 * PA_QN, PA_VH = PA_AT + 64 * AT_STRIDE * 4, PA_SM = PA_VH + 64 * KN_STRIDE * 2, PA_ITEM_LDS = PA_SM + 1024;
static_assert(2 * PA_ITEM_LDS <= LDS_BYTES, "PA LDS");

DI void tri_solve(f32x2 (&X)[64], const LAS float* A) {
#ifdef DBG_NO_SOLVE
    return;
#endif
    const unsigned a_u = (unsigned)(size_t)A;
#pragma unroll
    for (int i = 1; i < 64; ++i) {
        unsigned ai = a_u + i * AT_STRIDE * 4;
        asm volatile("" : "+v"(ai) : "v"(X[(i < 32) ? (i >= 2 ? i - 2 : 0) : i - 1].x));
        const LAS float* rowp = (const LAS float*)ai;
        f32x2 acc[4] = {X[i], {0.f, 0.f}, {0.f, 0.f}, {0.f, 0.f}};
#pragma unroll
        for (int j4 = 0; 4 * j4 < i; ++j4) {
            const f32x4 av = *(const LAS f32x4*)(rowp + 4 * j4);
            acc[0] = acc[0] - X[4 * j4] * av.x;
            if (4 * j4 + 1 < i) acc[1] = acc[1] - X[4 * j4 + 1] * av.y;
            if (4 * j4 + 2 < i) acc[2] = acc[2] - X[4 * j4 + 2] * av.z;
            if (4 * j4 + 3 < i) acc[3] = acc[3] - X[4 * j4 + 3] * av.w;
        }
        X[i] = (acc[0] + acc[1]) + (acc[2] + acc[3]);
    }
}

DI void pa_phase(const Args& a, LAS unsigned char* lds, int G, int tid, int lane, int wave) {
    unsigned char* ws = a.ws;
    const float* conv_qkv_w = a.in[3];
    bf16* ACT = (bf16*)(ws + WS_ACT); const bf16* HALO = (const bf16*)(ws + WS_HALO); bf16* Wb = (bf16*)(ws + WS_HB);
    const float* Gb = (const float*)(ws + WS_G); const float* Bb = (const float*)(ws + WS_BETA); float* EGL = (float*)(ws + WS_EGL);
    bf16* ATTN = (bf16*)a.out;
    const int sg = wave >> 2, role = (wave & 3) ^ (sg << 1), tsg = tid & 255;
    LAS unsigned char* base = lds + sg * PA_ITEM_LDS;
    LAS unsigned char* KnB = base + PA_KN; LAS unsigned char* QnB = base + PA_QN; LAS unsigned char* ATB = base + PA_AT; LAS unsigned char* VhB = base + PA_VH;
    LAS bf16* Kn = (LAS bf16*)KnB; LAS bf16* Qn = (LAS bf16*)QnB; LAS float* AT = (LAS float*)ATB; LAS float* sm = (LAS float*)(base + PA_SM);
#ifdef DBG_NO_ITEMS
    const int nrounds = 0;
#else
    const int nrounds = (NITEM + 2 * G - 1) / (2 * G);
#endif
    for (int round = 0; round < nrounds; ++round) {
        int ln, tsl;
        const int item = (round * G + (int)blockIdx.x) * 2 + sg; const bool valid = item < NITEM;
        const int h = item & 7, c = (item >> 3) & 31, b = item >> 8; const size_t row0 = (size_t)b * T + (size_t)c * CH;
        ln = lane; tsl = tsg; asm volatile("" : "+v"(ln), "+v"(tsl));
        if (valid) {
            const int seg = tsl & 15, rr0 = tsl >> 4;
            const bf16* hb_ = HALO + ((size_t)(b * NCH + c - 1) * 3) * 3072 + h * HD + seg * 8;
            const bf16* gb_ = ACT + row0 * 1024 + h * HD + seg * 8;
#pragma unroll
            for (int tens = 0; tens < 3; ++tens) {
                LAS unsigned char* dreg = (tens == 0 ? QnB : (tens == 1 ? KnB : ATB)) + seg * 16;
                v4u v[5];
#pragma unroll
                for (int k = 0; k < 5; ++k) { const int rr = rr0 + 16 * k; v[k] = (v4u){0u, 0u, 0u, 0u};
                    if (rr < 67) { if (rr >= 3) v[k] = *(const v4u*)(gb_ + (size_t)tens * ACTSZ + (size_t)(rr - 3) * 1024); else if (c > 0) v[k] = *(const v4u*)(hb_ + (size_t)rr * 3072 + tens * 1024); } }
#pragma unroll
                for (int k = 0; k < 5; ++k) { const int rr = rr0 + 16 * k; if (rr < 67) *(LAS v4u*)(dreg + rr * 256) = v[k]; }
            }
        }
        __syncthreads();
        ln = lane; tsl = tsg; asm volatile("" : "+v"(ln), "+v"(tsl));
        if (valid && role < 3) {
            const int ti = (role == 0) ? 2 : (role == 1 ? 1 : 0);
            const LAS unsigned* rp = (const LAS unsigned*)(role == 0 ? ATB : (role == 1 ? KnB : QnB)) + ln;
            const float* cwp = conv_qkv_w + ti * 1024 + h * HD + 2 * ln;
            f32x2 cw[4];
#pragma unroll
            for (int j = 0; j < 4; ++j) { cw[j].x = cwp[j * 3072]; cw[j].y = cwp[j * 3072 + 1]; }
            f32x2 val[64];
            unsigned x0 = rp[0], x1 = rp[64], x2 = rp[128];
#pragma unroll
            for (int i = 0; i < 64; ++i) { const unsigned x3 = rp[(i + 3) * 64];
                f32x2 s;
                s.x = cw[0].x * bf_lo(x0) + cw[1].x * bf_lo(x1) + cw[2].x * bf_lo(x2) + cw[3].x * bf_lo(x3);
                s.y = cw[0].y * bf_hi(x0) + cw[1].y * bf_hi(x1) + cw[2].y * bf_hi(x2) + cw[3].y * bf_hi(x3);
#ifdef DBG_COPY_V
                val[i].x = bf_lo(x3); val[i].y = bf_hi(x3);
#else
                val[i].x = silu_f(s.x); val[i].y = silu_f(s.y);
#endif
                x0 = x1; x1 = x2; x2 = x3; }
            LAS unsigned* dst = (LAS unsigned*)(role == 0 ? VhB : (role == 1 ? KnB : QnB)) + ln;
            if (role != 0) {
                const float sc = (role == 2) ? 0.08838834764831845f : 1.f;
#pragma unroll
                for (int hb = 0; hb < 64; hb += 32) {
                    float ssq[32];
#pragma unroll
                    for (int i = 0; i < 32; ++i) ssq[i] = val[hb + i].x * val[hb + i].x + val[hb + i].y * val[hb + i].y;
#pragma unroll
                    for (int i = 0; i < 32; ++i) ssq[i] += DPP_MOV(ssq[i], 0xB1);
#pragma unroll
                    for (int i = 0; i < 32; ++i) ssq[i] += DPP_MOV(ssq[i], 0x4E);
#pragma unroll
                    for (int i = 0; i < 32; ++i) ssq[i] += DPP_MOV(ssq[i], 0x141);
#pragma unroll
                    for (int i = 0; i < 32; ++i) ssq[i] += DPP_MOV(ssq[i], 0x140);
#pragma unroll
                    for (int i = 0; i < 32; ++i) ssq[i] += DPP_UPD0(ssq[i], 0x142, 0xA);
#pragma unroll
                    for (int i = 0; i < 32; ++i) ssq[i] += DPP_UPD0(ssq[i], 0x143, 0xC);
#pragma unroll
                    for (int i = 0; i < 32; ++i) { const float tot = __int_as_float(__builtin_amdgcn_readlane(__float_as_int(ssq[i]), 63)); const float rs = sc * __builtin_amdgcn_rsqf(tot + EPS);
                        dst[(hb + i) * (KN_STRIDE / 2)] = cvt_pk_bf16(val[hb + i].x * rs, val[hb + i].y * rs); }
                    __builtin_amdgcn_sched_barrier(0);
                }
            } else {
#pragma unroll
                for (int i = 0; i < 64; ++i) dst[i * (KN_STRIDE / 2)] = cvt_pk_bf16(val[i].x, val[i].y);
            }
        } else if (valid) {
#ifdef DBG_CONST_GATES
            float v = -0.05f; const float bi = 0.5f;
#else
            float v = Gb[(row0 + ln) * 8 + h]; const float bi = Bb[(row0 + ln) * 8 + h];
#endif
#pragma unroll
            for (int o = 1; o < 64; o <<= 1) { const float t = __shfl_up(v, o); if (ln >= o) v += t; }
            const float gl = __shfl(v, 63);
            sm[ln] = v; sm[64 + ln] = bi; sm[128 + ln] = __expf(v); sm[192 + ln] = __expf(gl - v);
            if (ln == 63) EGL[item] = __expf(v);
        }
        __syncthreads();
        ln = lane; tsl = tsg; asm volatile("" : "+v"(ln), "+v"(tsl));
        if (valid) {
            const int r = ln & 15, q = ln >> 4, ti_ = role;
            LDSV(LAS float*, smv, sm); LDSV(LAS float*, ATv, AT); LDSV(LAS bf16*, Knv, Kn); LDSV(LAS bf16*, Qnv, Qn);
            bf16x8 ki[4], qi[4];
#pragma unroll
            for (int s = 0; s < 4; ++s) { ki[s] = *(const LAS bf16x8*)(Knv + (16 * ti_ + r) * KN_STRIDE + 32 * s + 8 * q); qi[s] = *(const LAS bf16x8*)(Qnv + (16 * ti_ + r) * KN_STRIDE + 32 * s + 8 * q); }
            bf16* attn_i = ATTN + (size_t)item * 4096 + (16 * ti_ + r) * 64 + 8 * q;
            const float gci2 = smv[16 * ti_ + r], bi2 = smv[64 + 16 * ti_ + r];
#pragma unroll
            for (int tj = 0; tj < 4; ++tj) {
                bf16* ap = attn_i + 32 * (tj >> 1) + 4 * (tj & 1);
                if (tj <= ti_) {
                    f32x4 c1 = {0.f, 0.f, 0.f, 0.f}, c2 = {0.f, 0.f, 0.f, 0.f};
#pragma unroll
                    for (int s = 0; s < 4; ++s) { const bf16x8 kj = *(const LAS bf16x8*)(Knv + (16 * tj + r) * KN_STRIDE + 32 * s + 8 * q); c1 = MFMA16(kj, ki[s], c1); c2 = MFMA16(kj, qi[s], c2); }
                    const int i2 = 16 * ti_ + r; float p[4];
                    f32x4 o;
#pragma unroll
                    for (int e = 0; e < 4; ++e) { const int j2 = 16 * tj + 4 * q + e; o[e] = (j2 < i2) ? bi2 * __expf(gci2 - smv[j2]) * c1[e] : 0.f; }
                    { v2u na; na.x = cvt_pk_bf16(-o[0], -o[1]); na.y = cvt_pk_bf16(-o[2], -o[3]); *(LAS v2u*)((LAS unsigned char*)ATv + i2 * 144 + (16 * tj + 4 * q) * 2) = na; }
                    if (tj == ti_) *(LAS f32x4*)((LAS unsigned char*)ATv + 9216 + ((ti_ * 16 + r) * 16 + 4 * q) * 4) = o;
#pragma unroll
                    for (int e = 0; e < 4; ++e) { const int j2 = 16 * tj + 4 * q + e; p[e] = (j2 <= i2) ? __expf(gci2 - smv[j2]) * c2[e] : 0.f; }
                    v2u w; w.x = cvt_pk_bf16(p[0], p[1]); w.y = cvt_pk_bf16(p[2], p[3]); *(v2u*)ap = w;
                } else { v2u w; w.x = 0u; w.y = 0u; *(v2u*)ap = w; }
            }
        }
        __syncthreads();
        ln = lane; tsl = tsg; asm volatile("" : "+v"(ln), "+v"(tsl));
        if (valid) {
            LDSV(LAS float*, smv, sm); LDSV(LAS unsigned char*, QnBv, QnB); LDSV(LAS bf16*, Knv, Kn);
            for (int pc = tsl; pc < 1024; pc += 256) {
                const int i = pc >> 4, sg8 = pc & 15, s = sg8 >> 2, q = sg8 & 3; const float e = smv[128 + i];
                const v2u lo = *(const LAS v2u*)(QnBv + i * 272 + (32 * s + 4 * q) * 2), hi = *(const LAS v2u*)(QnBv + i * 272 + (32 * s + 16 + 4 * q) * 2);
                v4u o; o.x = cvt_pk_bf16(bf_lo(lo.x) * e, bf_hi(lo.x) * e); o.y = cvt_pk_bf16(bf_lo(lo.y) * e, bf_hi(lo.y) * e); o.z = cvt_pk_bf16(bf_lo(hi.x) * e, bf_hi(hi.x) * e); o.w = cvt_pk_bf16(bf_lo(hi.y) * e, bf_hi(hi.y) * e);
                *(v4u*)(ACT + (row0 + i) * 1024 + h * HD + sg8 * 8) = o; }
            for (int pc = tsl; pc < 1024; pc += 256) {
                const int dk = pc >> 3, g = pc & 7, s = g >> 2, q = g & 3; float f[8];
#pragma unroll
                for (int e = 0; e < 8; ++e) { const int j = 32 * s + 16 * (e >> 2) + 4 * q + (e & 3); f[e] = __uint_as_float((unsigned)Knv[j * KN_STRIDE + dk] << 16) * smv[192 + j]; }
                v4u o; o.x = cvt_pk_bf16(f[0], f[1]); o.y = cvt_pk_bf16(f[2], f[3]); o.z = cvt_pk_bf16(f[4], f[5]); o.w = cvt_pk_bf16(f[6], f[7]);
                *(v4u*)(ACT + ACTSZ + (row0 + (dk >> 1)) * 1024 + h * HD + (dk & 1) * 64 + g * 8) = o; }
        }
        __syncthreads();
        ln = lane; tsl = tsg; asm volatile("" : "+v"(ln), "+v"(tsl));
        f32x4 Rv[4][4];
        const int cbase = 64 * (role & 1);
        if (valid) {
            LDSV(LAS float*, smv, sm);
            const int r = ln & 15, q = ln >> 4;
            const LAS bf16* tile = (const LAS bf16*)(role < 2 ? VhB : KnB);
#pragma unroll
            for (int bb = 0; bb < 4; ++bb)
#pragma unroll
                for (int e = 0; e < 4; ++e) { const int row = 16 * bb + 4 * q + e; const float be = smv[64 + row], eg = smv[128 + row]; const float f = (role < 2) ? be : be * eg;
#pragma unroll
                    for (int nt = 0; nt < 4; ++nt) Rv[nt][bb][e] = __uint_as_float((unsigned)tile[row * KN_STRIDE + cbase + 16 * nt + r] << 16) * f; }
        }
        __syncthreads();
        ln = lane; tsl = tsg; asm volatile("" : "+v"(ln), "+v"(tsl));
        if (valid) {
            LAS unsigned char* XT = (role < 2 ? VhB : KnB);
            {   LAS unsigned char* zp = XT + cbase * 136 + ln * 16;
                const v4u z4 = {0u, 0u, 0u, 0u};
#pragma unroll
                for (int k = 0; k < 8; ++k) *(LAS v4u*)(zp + 1024 * k) = z4;
                if (ln < 32) *(LAS v4u*)(zp + 8192) = z4; }
            if (role == 0) {
                LDSV(LAS unsigned char*, ATu, ATB);
                const int tb = ln >> 4, tc = ln & 15;
                const LAS float* adg = (const LAS float*)(ATu + 9216) + tb * 256;
                float t[16];
#pragma unroll
                for (int i = 0; i < 16; ++i) { float acc = (tc == i) ? 1.f : 0.f;
#pragma unroll
                    for (int j4 = 0; 4 * j4 < i; ++j4) { const f32x4 av = *(const LAS f32x4*)(adg + i * 16 + 4 * j4);
                        acc -= av.x * t[4 * j4]; if (4 * j4 + 1 < i) acc -= av.y * t[4 * j4 + 1]; if (4 * j4 + 2 < i) acc -= av.z * t[4 * j4 + 2]; if (4 * j4 + 3 < i) acc -= av.w * t[4 * j4 + 3]; }
                    t[i] = acc; }
                LAS unsigned char* tp = ATu + 13312 + tb * 1024 + (8 * (tc >> 2) + (tc & 3)) * 2;
#pragma unroll
                for (int i = 0; i < 16; ++i) { const float to = DPP_MOV(t[i], 0xB1);
                    if ((tc & 1) == 0) *(LAS unsigned*)(tp + i * 64) = cvt_pk_bf16(t[i], to);
                    if ((tc & 3) == 0) { v2u z2; z2.x = 0u; z2.y = 0u; *(LAS v2u*)(tp + i * 64 + 8) = z2; } }
            }
        }
        __syncthreads();
        ln = lane; tsl = tsg; asm volatile("" : "+v"(ln), "+v"(tsl));
        if (valid) {
            LDSV(LAS unsigned char*, ATu, ATB);
            LAS unsigned char* XT = (role < 2 ? VhB : KnB);
            const int r = ln & 15, q = ln >> 4;
            LAS unsigned char* xcol = XT + (cbase + r) * 136;
#pragma unroll
            for (int bb = 0; bb < 4; ++bb) {
                const bf16x8 tf = *(const LAS bf16x8*)(ATu + 13312 + ((bb * 16 + r) * 32 + 8 * q) * 2);
                bf16x8 af[2];
#pragma unroll
                for (int ks = 0; ks < 2; ++ks) if (32 * ks < 16 * bb) af[ks] = *(const LAS bf16x8*)(ATu + (16 * bb + r) * 144 + (32 * ks + 8 * q) * 2);
#pragma unroll
                for (int nt = 0; nt < 4; ++nt) {
                    f32x4 acc = Rv[nt][bb];
#pragma unroll
                    for (int ks = 0; ks < 2; ++ks) if (32 * ks < 16 * bb) {
                        const v2u lo = *(const LAS v2u*)(xcol + nt * (16 * 136) + (32 * ks + 8 * q) * 2), hi = *(const LAS v2u*)(xcol + nt * (16 * 136) + (32 * ks + 8 * q) * 2 + 8);
                        v4u bw; bw.x = lo.x; bw.y = lo.y; bw.z = hi.x; bw.w = hi.y;
                        acc = MFMA16(af[ks], __builtin_bit_cast(bf16x8, bw), acc); }
                    v4u rw; rw.x = cvt_pk_bf16_v(acc[0], acc[1]); rw.y = cvt_pk_bf16_v(acc[2], acc[3]); rw.z = 0u; rw.w = 0u;
                    const f32x4 zero4 = {0.f, 0.f, 0.f, 0.f};
                    const f32x4 x = MFMA16(tf, __builtin_bit_cast(bf16x8, rw), zero4);
                    v2u xw; xw.x = cvt_pk_bf16_v(x[0], x[1]); xw.y = cvt_pk_bf16_v(x[2], x[3]);
                    *(LAS v2u*)(xcol + nt * (16 * 136) + (16 * bb + 4 * q) * 2) = xw;
                }
            }
        }
        __syncthreads();
        ln = lane; tsl = tsg; asm volatile("" : "+v"(ln), "+v"(tsl));
        if (valid) {
            for (int pc = tsl; pc < 2048; pc += 256) { const int which = pc >> 10, id = pc & 1023, i = id & 63, seg = id >> 6;
                const LAS bf16* xt = (const LAS bf16*)(which ? KnB : VhB) + i;
                unsigned short v[8];
#pragma unroll
                for (int e = 0; e < 8; ++e) { const int p = seg * 8 + e; const int col = which ? ((p & ~31) | (((p >> 2) & 1) << 4) | (((p >> 3) & 3) << 2) | (p & 3)) : p; v[e] = xt[col * 68]; }
                v4u o; o.x = (unsigned)v[0] | ((unsigned)v[1] << 16); o.y = (unsigned)v[2] | ((unsigned)v[3] << 16); o.z = (unsigned)v[4] | ((unsigned)v[5] << 16); o.w = (unsigned)v[6] | ((unsigned)v[7] << 16);
                bf16* dstp = which ? (Wb + (row0 + i) * 1024 + h * HD + seg * 8) : (ACT + 2 * ACTSZ + (row0 + i) * 1024 + h * HD + seg * 8);
                *(v4u*)dstp = o; }
        }
        __syncthreads();
    }
}

DI void yc_phase(const Args& a, int first, int G, int tid) {
    unsigned char* ws = a.ws; bf16* ACT = (bf16*)(ws + WS_ACT);
    {
        const float* conv_w = a.in[7]; const float* conv_b = a.in[8];
        const bf16* Pb = ACT + 4 * ACTSZ; bf16* Sb = ACT + 5 * ACTSZ;
        const int cgp = tid & 127, rq = tid >> 7, col = cgp * 8;
        float w0[8], w1[8], w2[8], bb[8];
#pragma unroll
        for (int e = 0; e < 8; ++e) { w0[e] = conv_w[col + e]; w1[e] = conv_w[1024 + col + e]; w2[e] = conv_w[2048 + col + e]; bb[e] = conv_b[col + e]; }
        for (int rc = (int)blockIdx.x - first; rc < M / 64; rc += G - first) {
            const size_t r0 = (size_t)rc * 64 + rq * 16;
            v4u pm2 = {0u, 0u, 0u, 0u}, pm1 = {0u, 0u, 0u, 0u};
            if ((r0 & (T - 1)) != 0) { pm2 = *(const v4u*)(Pb + (r0 - 2) * 1024 + col); pm1 = *(const v4u*)(Pb + (r0 - 1) * 1024 + col); }
#pragma unroll 4
            for (int i = 0; i < 16; ++i) {
                const v4u p0 = *(const v4u*)(Pb + (r0 + i) * 1024 + col); const v4u sv = *(const v4u*)(Sb + (r0 + i) * 1024 + col);
                v4u o;
#pragma unroll
                for (int e = 0; e < 4; ++e) {
                    const float ylo = bf_lo(sv[e]) * (w0[2 * e] * bf_lo(pm2[e]) + w1[2 * e] * bf_lo(pm1[e]) + w2[2 * e] * bf_lo(p0[e]) + bb[2 * e]);
                    const float yhi = bf_hi(sv[e]) * (w0[2 * e + 1] * bf_hi(pm2[e]) + w1[2 * e + 1] * bf_hi(pm1[e]) + w2[2 * e + 1] * bf_hi(p0[e]) + bb[2 * e + 1]);
                    o[e] = cvt_pk_bf16(ylo, yhi); }
                *(v4u*)(Sb + (r0 + i) * 1024 + col) = o;
                pm2 = pm1; pm1 = p0;
            }
        }
    }
}

constexpr int PB_W = 0, PB_Q = 64 * 272, PB_K = 2 * 64 * 272, PB_A = 3 * 64 * 272, PB_U = PB_A + 64 * 144, PB_BUF = PB_U + 64 * 144;
static_assert(2 * PB_BUF <= LDS_BYTES - 16, "PB LDS");
DI void pb_phase(const Args& a, LAS unsigned char* lds, int vcu, int G, int tid, int lane, int wave) {
    unsigned char* ws = a.ws;
    bf16* ACT = (bf16*)(ws + WS_ACT); const bf16* Wb = (const bf16*)(ws + WS_HB); const float* EGL = (const float*)(ws + WS_EGL);
    const bf16* ATTN = (const bf16*)a.out;
    const int r = lane & 15, q = lane >> 4;
    for (int unit = blockIdx.x; unit < 2 * BATCH * NH; unit += G) {
        const int half = (unit >> 3) & 1, bh = (unit & 7) + 8 * (unit >> 4), h = bh & 7, b = bh >> 3;
        if (wave >= 4) {
            const int tl = tid - 256;
            v4u st[16];
#define PB_ISSUE(c_) do { const size_t row0_ = (size_t)b * T + (size_t)(c_) * CH; const int item_ = (b * NCH + (c_)) * NH + h; \
                _Pragma("unroll") for (int k = 0; k < 12; ++k) { const int p = tl + 256 * (k & 3), rw = p >> 4, sg_ = p & 15; \
                    const bf16* src = (k < 4 ? Wb : (k < 8 ? (const bf16*)ACT : (const bf16*)(ACT + ACTSZ))) + (row0_ + rw) * 1024 + h * HD + sg_ * 8; st[k] = *(const v4u*)src; } \
                _Pragma("unroll") for (int k = 12; k < 14; ++k) { const int p = tl + 256 * (k - 12); st[k] = *(const v4u*)(ATTN + (size_t)item_ * 4096 + (p >> 3) * 64 + (p & 7) * 8); } \
                _Pragma("unroll") for (int k = 14; k < 16; ++k) { const int p = tl + 256 * (k - 14); st[k] = *(const v4u*)(ACT + 2 * ACTSZ + (row0_ + (p >> 3)) * 1024 + h * HD + 64 * half + (p & 7) * 8); } } while (0)
#define PB_COMMIT(buf_) do { LAS unsigned char* bb_ = lds + (buf_) * PB_BUF; \
                _Pragma("unroll") for (int k = 0; k < 12; ++k) { const int p = tl + 256 * (k & 3), rw = p >> 4, sg_ = p & 15; *(LAS v4u*)(bb_ + (k >> 2) * (64 * 272) + rw * 272 + sg_ * 16) = st[k]; } \
                _Pragma("unroll") for (int k = 12; k < 14; ++k) { const int p = tl + 256 * (k - 12); *(LAS v4u*)(bb_ + PB_A + (p >> 3) * 144 + (p & 7) * 16) = st[k]; } \
                _Pragma("unroll") for (int k = 14; k < 16; ++k) { const int p = tl + 256 * (k - 14); *(LAS v4u*)(bb_ + PB_U + (p >> 3) * 144 + (p & 7) * 16) = st[k]; } } while (0)
            PB_ISSUE(0); PB_COMMIT(0); PB_ISSUE(1);
            __syncthreads();
            for (int c = 0; c < NCH; ++c) {
                if (c + 1 < NCH) PB_COMMIT((c + 1) & 1);
                if (c + 2 < NCH) PB_ISSUE(c + 2);
                __syncthreads();
            }
#undef PB_ISSUE
#undef PB_COMMIT
        } else {
            const int sl = 4 * half + wave;
            const float eglv = (lane < NCH) ? EGL[(b * NCH + lane) * NH + h] : 0.f;
            f32x4 S[8];
#pragma unroll
            for (int tm = 0; tm < 8; ++tm) S[tm] = (f32x4){0.f, 0.f, 0.f, 0.f};
            __syncthreads();
            for (int c = 0; c < NCH; ++c) {
                const size_t row0 = (size_t)b * T + (size_t)c * CH; const int item = (b * NCH + c) * NH + h;
                const LAS unsigned char* bb = lds + (c & 1) * PB_BUF;
                const LAS unsigned char* wp = bb + PB_W + r * 272 + q * 16;
                const LAS unsigned char* qp = bb + PB_Q + r * 272 + q * 16;
                const LAS unsigned char* kp = bb + PB_K + (r >> 1) * 272 + (r & 1) * 128 + q * 16;
                const LAS unsigned char* ap = bb + PB_A + r * 144 + q * 16;
                const LAS bf16* uq = (const LAS bf16*)(bb + PB_U + (4 * q) * 144) + 16 * wave + r;
                const float egl = __int_as_float(__builtin_amdgcn_readlane(__float_as_int(eglv), c));
                bf16x8 Sb[4];
#pragma unroll
                for (int s = 0; s < 4; ++s) { v4u w; w.x = cvt_pk_bf16_v(S[2 * s][0], S[2 * s][1]); w.y = cvt_pk_bf16_v(S[2 * s][2], S[2 * s][3]); w.z = cvt_pk_bf16_v(S[2 * s + 1][0], S[2 * s + 1][1]); w.w = cvt_pk_bf16_v(S[2 * s + 1][2], S[2 * s + 1][3]);
                    Sb[s] = __builtin_bit_cast(bf16x8, w); }
                f32x4 vn[4], O[4];
#pragma unroll
                for (int t = 0; t < 4; ++t) {
                    f32x4 p = {0.f, 0.f, 0.f, 0.f}, o = {0.f, 0.f, 0.f, 0.f};
#pragma unroll
                    for (int s = 0; s < 4; ++s) { const bf16x8 wf = *(const LAS bf16x8*)(wp + t * (16 * 272) + s * 64); const bf16x8 qf = *(const LAS bf16x8*)(qp + t * (16 * 272) + s * 64);
                        p = MFMA16(wf, Sb[s], p); o = MFMA16(qf, Sb[s], o); }
#pragma unroll
                    for (int e = 0; e < 4; ++e) vn[t][e] = __uint_as_float((unsigned)uq[(16 * t + e) * 72] << 16) - p[e];
                    O[t] = o;
                }
                bf16x8 vb[2];
#pragma unroll
                for (int s = 0; s < 2; ++s) { v4u w; w.x = cvt_pk_bf16_v(vn[2 * s][0], vn[2 * s][1]); w.y = cvt_pk_bf16_v(vn[2 * s][2], vn[2 * s][3]); w.z = cvt_pk_bf16_v(vn[2 * s + 1][0], vn[2 * s + 1][1]); w.w = cvt_pk_bf16_v(vn[2 * s + 1][2], vn[2 * s + 1][3]);
                    vb[s] = __builtin_bit_cast(bf16x8, w); }
#pragma unroll
                for (int t = 0; t < 4; ++t) {
#pragma unroll
                    for (int s = 0; s < 2; ++s) { const bf16x8 af = *(const LAS bf16x8*)(ap + t * (16 * 144) + s * 64); O[t] = MFMA16(af, vb[s], O[t]); }
                }
#pragma unroll
                for (int tm = 0; tm < 8; ++tm) {
                    f32x4 acc = S[tm] * egl;
#pragma unroll
                    for (int s = 0; s < 2; ++s) { const bf16x8 kf = *(const LAS bf16x8*)(kp + tm * (8 * 272) + s * 64); acc = MFMA16(kf, vb[s], acc); }
                    S[tm] = acc;
                }
                bf16* up = ACT + 2 * ACTSZ + (row0 + 4 * q) * 1024 + h * HD + 16 * sl + r;
#pragma unroll
                for (int t = 0; t < 4; ++t)
#pragma unroll
                    for (int e = 0; e < 4; ++e) up[(size_t)(16 * t + e) * 1024] = (bf16)(cvt_pk_bf16_v(O[t][e], 0.f) & 0xffffu);
                __syncthreads();
            }
        }
    }
}

DI void pg_phase(const Args& a, int G, int tid) {
    unsigned char* ws = a.ws; const float* gw = a.in[6];
    bf16* ACT = (bf16*)(ws + WS_ACT); bf16* Ob = ACT + 2 * ACTSZ; const bf16* Zb = ACT + 3 * ACTSZ;
    const size_t total = (size_t)M * 128, stride = (size_t)G * 512;
    const int dv0 = (tid & 15) * 8;
    const f32x4 g0 = *(const f32x4*)(gw + dv0), g1 = *(const f32x4*)(gw + dv0 + 4);
    const float gg[8] = {g0.x, g0.y, g0.z, g0.w, g1.x, g1.y, g1.z, g1.w};
    for (size_t base = (size_t)blockIdx.x * 512 + tid; base < total; base += 8 * stride) {
        v4u ov[8], zv[8];
#pragma unroll
        for (int u = 0; u < 8; ++u) { const size_t idx = base + u * stride; if (idx < total) { const size_t m = idx >> 7; const int cgp = (int)(idx & 127);
            ov[u] = *(const v4u*)(Ob + m * 1024 + cgp * 8); zv[u] = *(const v4u*)(Zb + m * 1024 + cgp * 8); } }
#pragma unroll
        for (int u = 0; u < 8; ++u) { const size_t idx = base + u * stride; if (idx < total) { const size_t m = idx >> 7; const int cgp = (int)(idx & 127);
            float of[8], ss = 0.f;
#pragma unroll
            for (int e = 0; e < 4; ++e) { of[2 * e] = bf_lo(ov[u][e]); of[2 * e + 1] = bf_hi(ov[u][e]); ss += of[2 * e] * of[2 * e] + of[2 * e + 1] * of[2 * e + 1]; }
            ss = row16_sum(ss);
            const float rstd = __builtin_amdgcn_rsqf(ss * (1.f / HD) + EPS);
            v4u o;
#pragma unroll
            for (int e = 0; e < 4; ++e) o[e] = cvt_pk_bf16(of[2 * e] * rstd * gg[2 * e] * bf_lo(zv[u][e]), of[2 * e + 1] * rstd * gg[2 * e + 1] * bf_hi(zv[u][e]));
            *(v4u*)(Ob + m * 1024 + cgp * 8) = o; } }
    }
}

DI void p6_phase(const Args& a, int vcu, int G, int lane, int wave) {
    const float* fw = a.in[10];
    const int gw = vcu * NWAVES + wave, NGW = G * NWAVES;
    f32x4 w[4];
#pragma unroll
    for (int j = 0; j < 4; ++j) w[j] = ((const f32x4*)fw)[lane + 64 * j];
    for (int m = gw; m < M; m += 4 * NGW) {
        f32x4 v[4][4];
#pragma unroll
        for (int u = 0; u < 4; ++u) { const int mm = m + u * NGW; if (mm < M) { const f32x4* yr = (const f32x4*)(a.out + (size_t)mm * D) + lane;
#pragma unroll
            for (int j = 0; j < 4; ++j) v[u][j] = yr[64 * j]; } }
#pragma unroll
        for (int u = 0; u < 4; ++u) { const int mm = m + u * NGW; if (mm < M) { f32x4* yr = (f32x4*)(a.out + (size_t)mm * D) + lane; float s = 0.f;
#pragma unroll
            for (int j = 0; j < 4; ++j) s += (v[u][j].x * v[u][j].x + v[u][j].y * v[u][j].y) + (v[u][j].z * v[u][j].z + v[u][j].w * v[u][j].w);
            const float rstd = 1.f / sqrtf(wave_sum(s) * (1.f / D) + EPS);
#pragma unroll
            for (int j = 0; j < 4; ++j) yr[64 * j] = v[u][j] * rstd * w[j]; } }
    }
}

#ifndef MK_SKIP_GDN
#define MK_SKIP_GDN 0
#endif
__global__ void __launch_bounds__(NWAVES * 64, 2) hybrid_fwd(Args args) {
    extern __shared__ __attribute__((aligned(16))) unsigned char lds_raw[];
    cg::grid_group grid = cg::this_grid();
    LAS unsigned char* lds = (LAS unsigned char*)lds_raw;
    const int tid = threadIdx.x, lane = tid & 63, wave = __builtin_amdgcn_readfirstlane(tid >> 6);
    const int G = gridDim.x, bx = blockIdx.x;
    const int vcu = (G % 8 == 0) ? (bx % 8) * (G / 8) + bx / 8 : bx;
    unsigned char* ws = args.ws;
    bf16* ACT = (bf16*)(ws + WS_ACT);

    volatile LAS unsigned* xst = (volatile LAS unsigned*)(lds + LDS_BYTES - 16);
    if (tid < 4) xst[tid] = 0u;
    __syncthreads();
    XcdBarrier xbar = xcd_barrier_post((unsigned*)ws, xst);
#ifndef NO_P0
    p0_prologue(args, lds, vcu, G, tid, lane, wave);
#endif
    if (bx == 0 && tid < 64) ((unsigned*)(ws + WS_EGL + 32768))[16 * tid] = 0u;
#ifdef PROBE_P0X2
    __syncthreads();
    p0_prologue(args, lds, vcu, G, tid, lane, wave);
#endif
    grid.sync();
    {
        pg8::Gemm g{(const bf16*)(ws + WS_HB), (const bf16*)(ws + WS_WIN), M, N1, D, D, D / 64, 0};
        pg8::StaticOrder S; S.init(M, N1, G, bx);
        pg8::EpiProj E{ACT, (bf16*)(ws + WS_HALO), ACTSZ};
        pg8::gemm_phase<pg8::EpiProj, pg8::StaticOrder, true, true>(lds, g, S, E);
#ifdef PROBE_P1X2
        pg8::gemm_phase<pg8::EpiProj, pg8::StaticOrder, true, true>(lds, g, S, E);
#endif
    }
    xcd_barrier(xbar);
#ifndef NO_PA
    pa_phase(args, lds, G, tid, lane, wave);
#endif
    xcd_barrier(xbar);
#ifndef NO_PB
    pb_phase(args, lds, vcu, G, tid, lane, wave);
#endif
    if (G > 2 * BATCH * NH) { if (bx >= 2 * BATCH * NH) yc_phase(args, 2 * BATCH * NH, G, tid); } else yc_phase(args, 0, G, tid);
    xcd_barrier(xbar);
    pg_phase(args, G, tid);
    xcd_barrier(xbar);
    {
        pg8::Gemm g{ACT + 2 * ACTSZ, (const bf16*)(ws + WS_WOUT), M, D, KMIX, 1024, 16, (long)(3 * ACTSZ * 2)};
        pg8::StaticOrder S; S.init(M, D, G, bx);
        if (G == 256) {
            pg8::EpiResNorm E{args.in[0], args.out, args.in[10], (float*)(ws + WS_SSQ), (unsigned*)(ws + WS_EGL + 32768), D, EPS};
            pg8::gemm_phase<pg8::EpiResNorm, pg8::StaticOrder, false, true>(lds, g, S, E);
        } else {
            pg8::EpiRes E{args.in[0], args.out, D};
            pg8::gemm_phase<pg8::EpiRes, pg8::StaticOrder, true, true>(lds, g, S, E);
            grid.sync();
            p6_phase(args, vcu, G, lane, wave);
        }
    }
}

extern "C" void kernel_launch(void* const* d_in, const int* in_sizes, int n_in, void* d_out, int out_size, void* d_ws, size_t ws_size, hipStream_t stream) {
    static int grid = 0;
    if (grid == 0) {
        if (n_in != 11 || in_sizes[0] != M * D || out_size != M * D || ws_size < WS_END) { fprintf(stderr, "kernel_launch: unexpected shapes (n_in %d, in0 %d, out %d, ws %zu)\n", n_in, n_in > 0 ? in_sizes[0] : -1, out_size, ws_size); grid = -1; return; }
        int dev = 0, cus = 0, per_cu = 0;
        if (hipGetDevice(&dev) != hipSuccess || hipDeviceGetAttribute(&cus, hipDeviceAttributeMultiprocessorCount, dev) != hipSuccess) { grid = -1; return; }
        if (hipFuncSetAttribute((const void*)hybrid_fwd, hipFuncAttributeMaxDynamicSharedMemorySize, LDS_BYTES) != hipSuccess) { fprintf(stderr, "kernel_launch: hipFuncSetAttribute failed\n"); grid = -1; return; }
        if (hipOccupancyMaxActiveBlocksPerMultiprocessor(&per_cu, (const void*)hybrid_fwd, NWAVES * 64, LDS_BYTES) != hipSuccess || per_cu < 1) { fprintf(stderr, "kernel_launch: occupancy query gave %d\n", per_cu); (void)hipGetLastError(); per_cu = 1; }
        grid = cus * 1;
        if (grid > cus * per_cu) grid = cus * per_cu;
    }
    if (grid < 0) return;
    if (hipMemsetAsync(d_ws, 0, 16384, stream) != hipSuccess) { fprintf(stderr, "kernel_launch: memset of the barrier words failed\n"); return; }
    Args a{};
    for (int i = 0; i < 11; ++i) a.in[i] = (const float*)d_in[i];
    a.out = (float*)d_out; a.ws = (unsigned char*)d_ws;
    void* kargs[] = {&a};
    hipError_t e = hipLaunchCooperativeKernel((const void*)hybrid_fwd, dim3(grid), dim3(NWAVES * 64), kargs, LDS_BYTES, stream);
    if (e != hipSuccess) fprintf(stderr, "kernel_launch: cooperative launch failed: %s (grid %d)\n", hipGetErrorString(e), grid);
}
```

```cpp
#include <hip/hip_runtime.h>
#include <hip/hip_cooperative_groups.h>
#include <cstdio>
#include <cstdint>
namespace cg = cooperative_groups;
namespace pg8 {
#define PG8_LAS __attribute__((address_space(3)))
typedef unsigned short bf16_t;
typedef short bf16x8 __attribute__((ext_vector_type(8)));
typedef float f32x4 __attribute__((ext_vector_type(4)));
typedef unsigned u32x4 __attribute__((ext_vector_type(4)));
constexpr int BM = 256, BK = 64, HALF = 128, HTB = HALF * BK * 2  , STAGE_BYTES = 8 * HTB, NXCD = 8, WGM = 8;

__host__ __device__ __forceinline__ int lds_byte(int r, int c) { const int st = (r >> 4) * 2 + (c >> 5), rr = r & 15, cc = c & 31, ob = rr * 64 + cc * 2; return st * 1024 + (ob ^ (((ob >> 9) & 1) << 5)); }
__host__ __device__ __forceinline__ void stage_rc(int b, int& R, int& C) { const int st = b / 1024, sb = b % 1024, swz = sb ^ (((sb >> 9) & 1) << 5); R = (st >> 1) * 16 + swz / 64; C = (st & 1) * 32 + (swz % 64) / 2; }
__host__ __device__ __forceinline__ int perm32(int rho) { const int n = rho >> 4, i = rho & 15; return 8 * (i >> 2) + 4 * n + (i & 3); }

struct Unit { int pm, pn; };
struct Gemm { const bf16_t* A; const bf16_t* Bt; int M, N, K, lda, ksplit; long a2off; };

struct StaticOrder {
    int nM, nN, nwg, G, c;
    __host__ __device__ void init(int M, int N, int G_, int c_) { nM = M / BM; nN = N / BM; nwg = nM * nN; G = G_; c = c_; }
    __host__ __device__ bool next(int i, Unit& u) const {
        const long L = (long)i * G + c; if (L >= nwg) return false;
        int wgid = (int)L; { const int q = nwg / NXCD, r = nwg % NXCD, xcd = wgid % NXCD, off = wgid / NXCD; wgid = (xcd < r ? xcd * (q + 1) : r * (q + 1) + (xcd - r) * q) + off; }
        const int nig = WGM * nN, gid = wgid / nig, fm = gid * WGM, gsz = (nM - fm) < WGM ? (nM - fm) : WGM;
        u.pm = fm + ((wgid % nig) % gsz); u.pn = (wgid % nig) / gsz; return true;
    }
    __device__ __forceinline__ void a_ready(const Unit&) const {}
    __device__ __forceinline__ void done(const Unit&) const {}
};


typedef float f32x2_cv __attribute__((ext_vector_type(2)));
typedef __bf16 bf16x2_cv __attribute__((ext_vector_type(2)));
__device__ __forceinline__ unsigned cvt_pk_bf16_v(float lo, float hi) { f32x2_cv v = {lo, hi}; bf16x2_cv r = __builtin_convertvector(v, bf16x2_cv); return __builtin_bit_cast(unsigned, r); }
__device__ __forceinline__ unsigned cvt_pk_bf16(float lo, float hi) { unsigned r; asm volatile("v_cvt_pk_bf16_f32 %0, %1, %2" : "=v"(r) : "v"(lo), "v"(hi)); return r; }
__device__ __forceinline__ float silu_f(float x) { return x * __builtin_amdgcn_rcpf(1.f + __expf(-x)); }

struct EpiProj {
    static constexpr bool PERM = true, AFTER_DRAIN = false;
    bf16_t* ACT; bf16_t* HALO; size_t actsz;
    __device__ __forceinline__ void operator()(const f32x4 (&acc)[2][2][4][2], const Unit& u, int wr, int wc, int fr, int fq) const {
        const int pn = u.pn, row0 = u.pm * BM + wr * 64 + fr, cw = wc * 32 + 8 * fq;
        if (pn < 16) {
            bf16_t* base = ACT + (size_t)(pn >> 2) * actsz + (pn & 3) * 256 + cw;
            const bool act = pn >= 12, halo = pn < 12;
#pragma unroll
            for (int ai = 0; ai < 2; ++ai)
#pragma unroll
                for (int m = 0; m < 4; ++m) { const int row = row0 + ai * HALF + m * 16; bf16_t* rowp = base + (size_t)row * 1024;
#pragma unroll
                    for (int bj = 0; bj < 2; ++bj) { f32x4 v0 = acc[ai][bj][m][0], v1 = acc[ai][bj][m][1];
                        if (act) {
#pragma unroll
                            for (int j = 0; j < 4; ++j) { v0[j] = silu_f(v0[j]); v1[j] = silu_f(v1[j]); } }
                        u32x4 w; w.x = cvt_pk_bf16_v(v0[0], v0[1]); w.y = cvt_pk_bf16_v(v0[2], v0[3]); w.z = cvt_pk_bf16_v(v1[0], v1[1]); w.w = cvt_pk_bf16_v(v1[2], v1[3]);
                        *(u32x4*)(rowp + bj * HALF) = w;
                        if (m == 3 && halo && fr >= 13) *(u32x4*)(HALO + ((size_t)(row >> 6) * 3 + (fr - 13)) * 3072 + pn * 256 + bj * HALF + cw) = w; } }
        } else {
            const bool kind = pn >= 24; bf16_t* base = ACT + (size_t)(kind ? 5 : 4) * actsz + ((pn - 16) & 7) * 128 + cw;
#pragma unroll
            for (int ai = 0; ai < 2; ++ai)
#pragma unroll
                for (int m = 0; m < 4; ++m) { const int row = row0 + ai * HALF + m * 16;
                    f32x4 a0 = acc[ai][0][m][0], a1 = acc[ai][0][m][1], b0 = acc[ai][1][m][0], b1 = acc[ai][1][m][1];
                    if (kind) {
#pragma unroll
                        for (int j = 0; j < 4; ++j) { b0[j] = silu_f(b0[j]); b1[j] = silu_f(b1[j]); } }
                    a0 = a0 * b0; a1 = a1 * b1;
                    u32x4 w; w.x = cvt_pk_bf16(a0[0], a0[1]); w.y = cvt_pk_bf16(a0[2], a0[3]); w.z = cvt_pk_bf16(a1[0], a1[1]); w.w = cvt_pk_bf16(a1[2], a1[3]);
                    *(u32x4*)(base + (size_t)row * 1024) = w; }
        }
    }
};
struct EpiResNorm {
    static constexpr bool PERM = false, AFTER_DRAIN = true;
    const float* X; float* Y; const float* FW; float* part; unsigned* cnt; int ldc; float eps;
    __device__ __forceinline__ void operator()(const f32x4 (&)[2][2][4][2], const Unit&, int, int, int, int) const {}
    __device__ __forceinline__ void fused(const f32x4 (&acc)[2][2][4][2], const Unit& u, int wr, int wc, int fr, int fq, PG8_LAS unsigned char* lds, int wid, int lane) const {
        PG8_LAS float* red = (PG8_LAS float*)lds;
        PG8_LAS float* rs = (PG8_LAS float*)(lds + 4096);
        const int row0 = u.pm * BM + wr * 64 + fr, col0 = u.pn * BM + wc * 32 + 4 * fq; int tid = threadIdx.x; asm volatile("" : "+v"(tid));
#pragma unroll
        for (int ai = 0; ai < 2; ++ai)
#pragma unroll
            for (int m = 0; m < 4; ++m) { const size_t o = (size_t)(row0 + ai * HALF + m * 16) * ldc + col0; float ss = 0.f;
#pragma unroll
                for (int bj = 0; bj < 2; ++bj)
#pragma unroll
                    for (int n = 0; n < 2; ++n) { const f32x4 y = acc[ai][bj][m][n] + *(const f32x4*)(X + o + bj * HALF + n * 16); ss += (y.x * y.x + y.y * y.y) + (y.z * y.z + y.w * y.w); }
                ss += __shfl_xor(ss, 16); ss += __shfl_xor(ss, 32);
                if (fq == 0) red[((wr * 4 + wc) * 8 + ai * 4 + m) * 16 + fr] = ss; }
        __syncthreads();
        if (tid < 256) { const int w_ = (tid >> 6) & 1, ai = tid >> 7, m = (tid >> 4) & 3, f = tid & 15; float s = 0.f;
#pragma unroll
            for (int c = 0; c < 4; ++c) s += red[((w_ * 4 + c) * 8 + ai * 4 + m) * 16 + f];
            __hip_atomic_store(part + (size_t)(u.pm * BM + tid) * 4 + u.pn, s, __ATOMIC_RELAXED, __HIP_MEMORY_SCOPE_AGENT); }
        asm volatile("s_waitcnt vmcnt(0)" ::: "memory");
        __syncthreads();
        if (tid == 0) { __hip_atomic_fetch_add(cnt + 16 * u.pm, 1u, __ATOMIC_RELAXED, __HIP_MEMORY_SCOPE_AGENT);
            while (__hip_atomic_load(cnt + 16 * u.pm, __ATOMIC_RELAXED, __HIP_MEMORY_SCOPE_AGENT) < 4u) __builtin_amdgcn_s_sleep(2); }
        __syncthreads();
        if (tid < 256) { const float* pp = part + (size_t)(u.pm * BM + tid) * 4; float s = 0.f;
#pragma unroll
            for (int c = 0; c < 4; ++c) s += __hip_atomic_load(pp + c, __ATOMIC_RELAXED, __HIP_MEMORY_SCOPE_AGENT);
            rs[tid] = 1.f / sqrtf(s * (1.f / 1024.f) + eps); }
        __syncthreads();
        f32x4 fw[2][2];
#pragma unroll
        for (int bj = 0; bj < 2; ++bj)
#pragma unroll
            for (int n = 0; n < 2; ++n) fw[bj][n] = *(const f32x4*)(FW + col0 + bj * HALF + n * 16);
#pragma unroll
        for (int ai = 0; ai < 2; ++ai)
#pragma unroll
            for (int m = 0; m < 4; ++m) { const size_t o = (size_t)(row0 + ai * HALF + m * 16) * ldc + col0; const float rstd = rs[ai * HALF + wr * 64 + m * 16 + fr];
#pragma unroll
                for (int bj = 0; bj < 2; ++bj)
#pragma unroll
                    for (int n = 0; n < 2; ++n) { const f32x4 y = acc[ai][bj][m][n] + *(const f32x4*)(X + o + bj * HALF + n * 16); *(f32x4*)(Y + o + bj * HALF + n * 16) = y * rstd * fw[bj][n]; } }
    }
};
struct EpiRes {
    static constexpr bool PERM = false, AFTER_DRAIN = false;
    const float* X; float* Y; int ldc;
    __device__ __forceinline__ void operator()(const f32x4 (&acc)[2][2][4][2], const Unit& u, int wr, int wc, int fr, int fq) const {
        const int row0 = u.pm * BM + wr * 64 + fr, col0 = u.pn * BM + wc * 32 + 4 * fq;
#pragma unroll
        for (int ai = 0; ai < 2; ++ai)
#pragma unroll
            for (int m = 0; m < 4; ++m) { const size_t o = (size_t)(row0 + ai * HALF + m * 16) * ldc + col0;
#pragma unroll
                for (int bj = 0; bj < 2; ++bj)
#pragma unroll
                    for (int n = 0; n < 2; ++n) *(f32x4*)(Y + o + bj * HALF + n * 16) = acc[ai][bj][m][n] + *(const f32x4*)(X + o + bj * HALF + n * 16); }
    }
};

template <class Epi, class Sched, bool ALIGN_EPI = false, bool SP2 = false>
__device__ __forceinline__ void gemm_phase(PG8_LAS unsigned char* lds, const Gemm g, const Sched& S, const Epi& E) {
    const int tid = threadIdx.x, wid = __builtin_amdgcn_readfirstlane(tid >> 6), lane = tid & 63, wr = wid >> 2, wc = wid & 3, fr = lane & 15, fq = lane >> 4;
    const int K = g.K, nt = K / BK, lda = g.lda, ksplit = g.ksplit; const long a2off = g.a2off;
    unsigned voffA[2], voffB[2];
#pragma unroll
    for (int i = 0; i < 2; ++i) { int R, C; stage_rc(tid * 16 + i * 8192, R, C); const int Rb = Epi::PERM ? ((R & ~31) + perm32(R & 31)) : R;
        voffA[i] = (unsigned)(R * lda + C) * 2u; voffB[i] = (unsigned)(Rb * K + C) * 2u; }
    const size_t kstep = (size_t)(BK * 2);
    const size_t hstep = (size_t)HALF * K * 2;
    const size_t tstep = 2 * hstep; const size_t hstepA = (size_t)HALF * lda * 2, tstepA = 2 * hstepA;
#define PG8_AK(base, t) ((base) + (((t) < ksplit) ? (long)(t) * (long)kstep : a2off + (long)((t) - ksplit) * (long)kstep))
    const unsigned ldsw = (unsigned)wid * 1024u;
    const int aoff = lds_byte(wr * 64 + fr, fq * 8), boff = lds_byte(wc * 32 + fr, fq * 8);
#define PG8_SA(b, h) (((b) * 2 + (h)) * HTB)
#define PG8_SB(b, h) ((4 + (b) * 2 + (h)) * HTB)
#define PG8_STAGE(bufoff, gbase, voff) do { _Pragma("unroll") for (int _i = 0; _i < 2; ++_i) \
        __builtin_amdgcn_global_load_lds((const unsigned*)((const char*)(gbase) + (voff)[_i]), (PG8_LAS unsigned*)(lds + (bufoff) + ldsw + _i * 8192), 16, 0, 0); } while (0)
#define PG8_LDA(dst, b, h) do { _Pragma("unroll") for (int m = 0; m < 4; ++m) _Pragma("unroll") for (int k = 0; k < 2; ++k) dst[m][k] = *(const PG8_LAS bf16x8*)(lds + PG8_SA(b, h) + aoff + m * 2048 + k * 1024); } while (0)
#define PG8_LDB(dst, b, h) do { _Pragma("unroll") for (int n = 0; n < 2; ++n) _Pragma("unroll") for (int k = 0; k < 2; ++k) dst[n][k] = *(const PG8_LAS bf16x8*)(lds + PG8_SB(b, h) + boff + n * 2048 + k * 1024); } while (0)
#define PG8_MMA(ai, bj, At, Bt) do { __builtin_amdgcn_s_setprio(1); _Pragma("unroll") for (int m = 0; m < 4; ++m) _Pragma("unroll") for (int n = 0; n < 2; ++n) _Pragma("unroll") for (int k = 0; k < 2; ++k) \
        acc[ai][bj][m][n] = __builtin_amdgcn_mfma_f32_16x16x32_bf16(Bt[n][k], At[m][k], acc[ai][bj][m][n], 0, 0, 0); __builtin_amdgcn_s_setprio(0); } while (0)
#define PG8_WAIT_V(n) asm volatile("s_waitcnt vmcnt(" #n ")" ::: "memory")
#define PG8_WAIT_L(n) asm volatile("s_waitcnt lgkmcnt(" #n ")" ::: "memory")
#define PG8_BAR __builtin_amdgcn_s_barrier()
#define PG8_SCHED __builtin_amdgcn_sched_barrier(0)
    Unit cur, nxt; int ui = 0;
    if (!S.next(0, cur)) return;
    f32x4 acc[2][2][4][2];
#pragma unroll
    for (int a = 0; a < 2; ++a)
#pragma unroll
        for (int b = 0; b < 2; ++b)
#pragma unroll
            for (int m = 0; m < 4; ++m)
#pragma unroll
                for (int n = 0; n < 2; ++n) acc[a][b][m][n] = (f32x4){0.f, 0.f, 0.f, 0.f};
    bf16x8 At[4][2], B0[2][2], B1[2][2];
    const char* cA = (const char*)g.A + (size_t)cur.pm * tstepA; const char* cB = (const char*)g.Bt + (size_t)cur.pn * tstep;
    S.a_ready(cur);
    if constexpr (SP2) {
        PG8_STAGE(PG8_SB(0, 0), cB, voffB); PG8_STAGE(PG8_SB(0, 1), cB + hstep, voffB); PG8_STAGE(PG8_SA(0, 0), cA, voffA); PG8_STAGE(PG8_SA(0, 1), cA + hstepA, voffA);
        if (wr == 1) PG8_BAR;
        PG8_WAIT_V(2); PG8_BAR;
        PG8_STAGE(PG8_SB(1, 0), cB + kstep, voffB); PG8_STAGE(PG8_SA(1, 0), cA + kstep, voffA); PG8_STAGE(PG8_SB(1, 1), cB + hstep + kstep, voffB);
        PG8_WAIT_V(6); PG8_BAR;
    } else {
        PG8_STAGE(PG8_SB(0, 0), cB, voffB); PG8_STAGE(PG8_SA(0, 0), cA, voffA); PG8_STAGE(PG8_SB(0, 1), cB + hstep, voffB); PG8_STAGE(PG8_SA(0, 1), cA + hstepA, voffA);
        if (wr == 1) PG8_BAR;
        PG8_WAIT_V(4); PG8_BAR;
        PG8_STAGE(PG8_SB(1, 0), cB + kstep, voffB); PG8_STAGE(PG8_SA(1, 0), cA + kstep, voffA); PG8_STAGE(PG8_SB(1, 1), cB + hstep + kstep, voffB);
        PG8_WAIT_V(6); PG8_BAR;
    }
    for (;;) {
        const bool has_next = S.next(ui + 1, nxt);
        const char* nA = has_next ? (const char*)g.A + (size_t)nxt.pm * tstepA : cA; const char* nB = has_next ? (const char*)g.Bt + (size_t)nxt.pn * tstep : cB;
        for (int t = 0; t < nt; t += 2) {
            const bool last = (t == nt - 2);
            const char* a1 = PG8_AK(cA, t + 1);
            const char* a2 = last ? nA : PG8_AK(cA, t + 2); const char* b2 = last ? nB : cB + (size_t)(t + 2) * kstep;
            const char* a3 = last ? nA + kstep : PG8_AK(cA, t + 3); const char* b3 = b2 + kstep;
            if (last && has_next) S.a_ready(nxt);
            if constexpr (SP2) {
            PG8_LDB(B0, 0, 0); PG8_LDB(B1, 0, 1); PG8_SCHED; PG8_LDA(At, 0, 0); PG8_STAGE(PG8_SA(1, 1), a1 + hstepA, voffA);
            PG8_WAIT_V(8); PG8_WAIT_L(0); PG8_BAR; PG8_MMA(0, 0, At, B0); PG8_MMA(0, 1, At, B1); PG8_BAR; PG8_SCHED;
            PG8_LDA(At, 0, 1); PG8_STAGE(PG8_SB(0, 0), b2, voffB); PG8_STAGE(PG8_SB(0, 1), b2 + hstep, voffB); PG8_STAGE(PG8_SA(0, 0), a2, voffA);
            PG8_WAIT_V(8); PG8_WAIT_L(0); PG8_BAR; PG8_MMA(1, 0, At, B0); PG8_MMA(1, 1, At, B1); PG8_BAR; PG8_SCHED;
            PG8_LDB(B0, 1, 0); PG8_LDB(B1, 1, 1); PG8_SCHED; PG8_LDA(At, 1, 0); PG8_STAGE(PG8_SA(0, 1), a2 + hstepA, voffA);
            PG8_WAIT_V(8); PG8_WAIT_L(0); PG8_BAR; PG8_MMA(0, 0, At, B0); PG8_MMA(0, 1, At, B1); PG8_BAR; PG8_SCHED;
            PG8_LDA(At, 1, 1); PG8_STAGE(PG8_SB(1, 0), b3, voffB); PG8_STAGE(PG8_SB(1, 1), b3 + hstep, voffB); PG8_STAGE(PG8_SA(1, 0), a3, voffA);
            PG8_WAIT_V(8); PG8_WAIT_L(0); PG8_BAR; PG8_MMA(1, 0, At, B0); PG8_MMA(1, 1, At, B1); PG8_BAR; PG8_SCHED;
            } else {
            PG8_LDB(B0, 0, 0); PG8_SCHED; PG8_LDA(At, 0, 0); PG8_STAGE(PG8_SA(1, 1), a1 + hstepA, voffA);
            PG8_WAIT_L(8); PG8_BAR; PG8_WAIT_L(0); PG8_MMA(0, 0, At, B0); PG8_BAR; PG8_SCHED;
            PG8_LDB(B1, 0, 1); PG8_STAGE(PG8_SB(0, 0), b2, voffB);
            PG8_BAR; PG8_WAIT_L(0); PG8_MMA(0, 1, At, B1); PG8_BAR;
            PG8_LDA(At, 0, 1); PG8_STAGE(PG8_SA(0, 0), a2, voffA);
            PG8_BAR; PG8_WAIT_L(0); PG8_MMA(1, 0, At, B0); PG8_BAR; PG8_SCHED;
            PG8_STAGE(PG8_SB(0, 1), b2 + hstep, voffB);
            PG8_WAIT_V(6); PG8_BAR; PG8_MMA(1, 1, At, B1); PG8_BAR;
            PG8_LDB(B0, 1, 0); PG8_SCHED; PG8_LDA(At, 1, 0); PG8_STAGE(PG8_SA(0, 1), a2 + hstepA, voffA);
            PG8_WAIT_L(8); PG8_BAR; PG8_WAIT_L(0); PG8_MMA(0, 0, At, B0); PG8_BAR; PG8_SCHED;
            PG8_LDB(B1, 1, 1); PG8_STAGE(PG8_SB(1, 0), b3, voffB);
            PG8_BAR; PG8_WAIT_L(0); PG8_MMA(0, 1, At, B1); PG8_BAR;
            PG8_LDA(At, 1, 1); PG8_STAGE(PG8_SA(1, 0), a3, voffA);
            PG8_BAR; PG8_WAIT_L(0); PG8_MMA(1, 0, At, B0); PG8_BAR; PG8_SCHED;
            PG8_STAGE(PG8_SB(1, 1), b3 + hstep, voffB);
            PG8_WAIT_V(6); PG8_BAR; PG8_MMA(1, 1, At, B1); PG8_BAR;
            }
        }
        if constexpr (ALIGN_EPI) { if (wr == 0) PG8_BAR; }
        if constexpr (!Epi::AFTER_DRAIN) { E(acc, cur, wr, wc, fr, fq); S.done(cur); }
        if (!has_next) break;
#pragma unroll
        for (int a = 0; a < 2; ++a)
#pragma unroll
            for (int b = 0; b < 2; ++b)
#pragma unroll
                for (int m = 0; m < 4; ++m)
#pragma unroll
                    for (int n = 0; n < 2; ++n) acc[a][b][m][n] = (f32x4){0.f, 0.f, 0.f, 0.f};
        cur = nxt; cA = nA; cB = nB; ++ui;
        if constexpr (ALIGN_EPI) { if (wr == 1) PG8_BAR; }
    }
    PG8_WAIT_V(0);
    if constexpr (!ALIGN_EPI) { if (wr == 0) PG8_BAR; }
    PG8_BAR;
    if constexpr (Epi::AFTER_DRAIN) { E.fused(acc, cur, wr, wc, fr, fq, lds, wid, lane); S.done(cur); }
#undef PG8_AK
#undef PG8_SA
#undef PG8_SB
#undef PG8_STAGE
#undef PG8_LDA
#undef PG8_LDB
#undef PG8_MMA
#undef PG8_WAIT_V
#undef PG8_WAIT_L
#undef PG8_BAR
#undef PG8_SCHED
}
}


constexpr int BATCH = 8, T = 2048, D = 1024, M = BATCH * T, NH = 8, HD = 128, PW = 8208, N1 = 8192, KMIX = 2048, CH = 64, NCH = T / CH;
constexpr int NITEM = BATCH * NCH * NH;
constexpr float EPS = 1e-6f;
constexpr int NWAVES = 8;
constexpr size_t MiB = 1u << 20;
constexpr size_t WS_WIN = 1 * MiB;
constexpr size_t WS_WOUT = 17 * MiB;
constexpr size_t WS_G = 21 * MiB;
constexpr size_t WS_BETA = WS_G + 512 * 1024;
constexpr size_t WS_HALO = 22 * MiB;
constexpr size_t WS_EGL = 27 * MiB;
constexpr size_t WS_SSQ = 28 * MiB;
constexpr size_t WS_HB = 32 * MiB;
constexpr size_t WS_ACT = 64 * MiB;
constexpr size_t ACTSZ = (size_t)M * 1024;
constexpr size_t WS_END = 256 * MiB;
static_assert(WS_ACT + 6 * ACTSZ * 2 == WS_END, "ws map");
constexpr int LDS_BYTES = 147456;

#define LAS __attribute__((address_space(3)))
#define DI __device__ __forceinline__
typedef unsigned short bf16;
typedef unsigned v4u __attribute__((ext_vector_type(4)));
typedef unsigned v2u __attribute__((ext_vector_type(2)));
typedef float f32x4 __attribute__((ext_vector_type(4)));
typedef float f32x2 __attribute__((ext_vector_type(2)));
typedef short bf16x8 __attribute__((ext_vector_type(8)));
using pg8::cvt_pk_bf16;
using pg8::cvt_pk_bf16_v;
using pg8::silu_f;
DI float bf_lo(unsigned u) { return __uint_as_float(u << 16); }
DI float bf_hi(unsigned u) { return __uint_as_float(u & 0xffff0000u); }
#define DPP_MOV(x, ctrl) __int_as_float(__builtin_amdgcn_mov_dpp(__float_as_int(x), (ctrl), 0xF, 0xF, true))
#define DPP_UPD0(x, ctrl, rmask) __int_as_float(__builtin_amdgcn_update_dpp(0, __float_as_int(x), (ctrl), (rmask), 0xF, false))
DI float row16_sum(float v) { v += DPP_MOV(v, 0xB1); v += DPP_MOV(v, 0x4E); v += DPP_MOV(v, 0x141); v += DPP_MOV(v, 0x140); return v; }
DI float wave_sum(float v) {
    v = row16_sum(v);
    v += DPP_UPD0(v, 0x142, 0xA);
    v += DPP_UPD0(v, 0x143, 0xC);
    return __int_as_float(__builtin_amdgcn_readlane(__float_as_int(v), 63));
}
DI int posf(int idx) { return (idx & ~31) | (((idx >> 2) & 3) << 3) | (((idx >> 4) & 1) << 2) | (idx & 3); }
constexpr int permf(int p) { return (p & ~31) | (((p >> 2) & 1) << 4) | (((p >> 3) & 3) << 2) | (p & 3); }
#define LDSV(T, name, src) unsigned name##_u = (unsigned)(size_t)(src); asm volatile("" : "+v"(name##_u)); T name = (T)name##_u
#ifndef DBG_NO_HALO
#define DBG_NO_HALO 0
#endif
#define MFMA16(a, b, c) __builtin_amdgcn_mfma_f32_16x16x32_bf16((a), (b), (c), 0, 0, 0)

struct Args { const float* in[11]; float* out; unsigned char* ws; };

#define XB_TMO      128
#define XB_XCNT(j)  (256  + 64 * (j))
#define XB_XSUB(j)  (1280 + 64 * (j))
#define XB_XGEN(j)  (2304 + 64 * (j))
#define XB_TOP      3328
#define XB_TOPGEN   3392
#define XCD_BAR_WORDS 3456
#define XB_SPIN_CAP (1u << 18)

__device__ __forceinline__ unsigned xb_ld(unsigned* p)              { return __hip_atomic_load(p, __ATOMIC_RELAXED, __HIP_MEMORY_SCOPE_AGENT); }
__device__ __forceinline__ unsigned xb_add(unsigned* p, unsigned v) { return __hip_atomic_fetch_add(p, v, __ATOMIC_RELAXED, __HIP_MEMORY_SCOPE_AGENT); }
__device__ __forceinline__ unsigned xb_xcc_id() { return (unsigned)__builtin_amdgcn_s_getreg((3 << 11) | 20) & 0xFu; }
#define XB_SPIN(cond, bar) do { unsigned _sp = 0; while (cond) { __builtin_amdgcn_s_sleep(1); \
    if ((++_sp & 255u) == 0u) { if (xb_ld(&(bar)[XB_TMO])) break; if (_sp > XB_SPIN_CAP) { atomicAdd(&(bar)[XB_TMO], 1u); break; } } } } while (0)

struct XcdBarrier {
    unsigned* bar; unsigned x;
    volatile LAS unsigned* st;
};

__device__ __forceinline__ XcdBarrier xcd_barrier_post(unsigned* bar, volatile LAS unsigned* st) {
    XcdBarrier b; b.bar = bar; b.x = xb_xcc_id(); b.st = st;
    if (threadIdx.x == 0) (void)xb_add(&bar[XB_XCNT(b.x)], 1u);
    return b;
}
__device__ __forceinline__ void xcd_barrier_complete(unsigned* bar, unsigned x, unsigned& nloc, unsigned& nx) {
    const unsigned G = gridDim.x * gridDim.y * gridDim.z;
    unsigned sum, cnt, mine, sp = 0u;
    for (;;) {
        sum = 0u; cnt = 0u; mine = 0u;
#pragma unroll
        for (unsigned j = 0; j < 16; ++j) { const unsigned c = xb_ld(&bar[XB_XCNT(j)]); sum += c; cnt += (c > 0u) ? 1u : 0u; mine = (j == x) ? c : mine; }
        if (sum == G) break;
        __builtin_amdgcn_s_sleep(1);
        if ((++sp & 255u) == 0u) { if (xb_ld(&bar[XB_TMO])) break; if (sp > XB_SPIN_CAP) { atomicAdd(&bar[XB_TMO], 1u); break; } }
    }
    nloc = mine > 0u ? mine : 1u; nx = cnt > 0u ? cnt : 1u;
}

__device__ __forceinline__ void xcd_barrier(const XcdBarrier& b) {
    asm volatile("s_waitcnt vmcnt(0)" ::: "memory");
    __syncthreads();
    if (threadIdx.x == 0) {
        unsigned* bar = b.bar;
        __builtin_amdgcn_s_waitcnt(0);
        unsigned nloc = b.st[0], nx = b.st[1];
        if (nloc == 0u) { xcd_barrier_complete(bar, b.x, nloc, nx); b.st[0] = nloc; b.st[1] = nx; }
        const unsigned old = xb_add(&bar[XB_XSUB(b.x)], 1u);
        const unsigned gen = old / nloc;
        if (old + 1u == (gen + 1u) * nloc) {
            __builtin_amdgcn_fence(__ATOMIC_RELEASE, "agent");
            asm volatile("s_waitcnt vmcnt(0)" ::: "memory");
            const unsigned og = xb_add(&bar[XB_TOP], 1u);
            const unsigned tg = og / nx;
            if (og + 1u == (tg + 1u) * nx) xb_add(&bar[XB_TOPGEN], 1u);
            else XB_SPIN(xb_ld(&bar[XB_TOPGEN]) == tg, bar);
            __builtin_amdgcn_fence(__ATOMIC_ACQUIRE, "agent");
            xb_add(&bar[XB_XGEN(b.x)], 1u);
            asm volatile("s_waitcnt vmcnt(0)" ::: "memory");
        } else {
            XB_SPIN(xb_ld(&bar[XB_XGEN(b.x)]) == gen, bar);
            __builtin_amdgcn_fence(__ATOMIC_ACQUIRE, "agent");
            asm volatile("s_waitcnt vmcnt(0)" ::: "memory");
        }
    }
    __syncthreads();
}


DI int srccol(int n0) {
    if (n0 < 4096) return n0;
    if (n0 < 6144) { const int r = n0 - 4096, tau = r >> 8, w = r & 255; return w < 128 ? 5136 + 128 * tau + w : 6160 + 128 * tau + (w - 128); }
    const int r = n0 - 6144, tau = r >> 8, w = r & 255; return w < 128 ? 4112 + 128 * tau + w : 7184 + 128 * tau + (w - 128);
}
DI void transpose_item(const float* W, int ldw, int srccol0, bf16* WT, int K, int n0, int k0, LAS float* scr, int lane) {
    f32x4 ld[8];
#pragma unroll
    for (int i = 0; i < 8; ++i) { const int pc = lane + 64 * i, kk = pc >> 3, n4 = pc & 7; ld[i] = *(const f32x4*)(W + (size_t)(k0 + kk) * ldw + srccol0 + 4 * n4); }
#pragma unroll
    for (int i = 0; i < 8; ++i) { const int pc = lane + 64 * i, kk = pc >> 3, n4 = pc & 7; LAS float* d = scr + kk * 33 + 4 * n4; d[0] = ld[i].x; d[1] = ld[i].y; d[2] = ld[i].z; d[3] = ld[i].w; }
    asm volatile("s_waitcnt lgkmcnt(0)" ::: "memory");
    const int c = lane & 7;
#pragma unroll
    for (int j = 0; j < 4; ++j) { const int n = (lane >> 3) + 8 * j; const LAS float* s = scr + (8 * c) * 33 + n;
        v4u o; o.x = cvt_pk_bf16(s[0 * 33], s[1 * 33]); o.y = cvt_pk_bf16(s[2 * 33], s[3 * 33]); o.z = cvt_pk_bf16(s[4 * 33], s[5 * 33]); o.w = cvt_pk_bf16(s[6 * 33], s[7 * 33]);
        *(v4u*)(WT + (size_t)(n0 + n) * K + k0 + 8 * c) = o; }
    asm volatile("s_waitcnt lgkmcnt(0)" ::: "memory");
}
DI void p0_prologue(const Args& a, LAS unsigned char* lds, int vcu, int G, int tid, int lane, int wave) {
    unsigned char* ws = a.ws;
    const float* x = a.in[0]; const float* norm_w = a.in[1]; const float* w_in = a.in[2]; const float* A_log = a.in[4]; const float* dt_bias = a.in[5]; const float* w_out = a.in[9];
    bf16* WinT = (bf16*)(ws + WS_WIN); bf16* WoutT = (bf16*)(ws + WS_WOUT); bf16* HB = (bf16*)(ws + WS_HB);
    float* Gb = (float*)(ws + WS_G); float* Bb = (float*)(ws + WS_BETA);
    LAS float* scr = (LAS float*)(lds + wave * 16384);
    const int gw = vcu * NWAVES + wave, NGW = G * NWAVES;
    constexpr int I_IN = (D / 64) * (N1 / 32), I_OUT = (KMIX / 64) * (D / 32);
#define P0_LOAD(dst, mb) do { _Pragma("unroll") for (int u = 0; u < 4; ++u) { const f32x4* xr_ = (const f32x4*)(x + (size_t)min((mb) + u * NGW, M - 1) * D) + lane; \
        _Pragma("unroll") for (int j = 0; j < 4; ++j) dst[u][j] = xr_[64 * j]; } } while (0)
    f32x4 vv[4][4], vnx[4][4];
    P0_LOAD(vv, gw);
    for (int it = gw; it < I_IN + I_OUT; it += NGW) {
        if (it < I_IN) { const int kb = it / (N1 / 32), nb = it % (N1 / 32); transpose_item(w_in, PW, srccol(32 * nb), WinT, D, 32 * nb, 64 * kb, scr, lane); }
        else { const int r = it - I_IN, kb = r / (D / 32), nb = r % (D / 32); transpose_item(w_out, D, 32 * nb, WoutT, KMIX, 32 * nb, 64 * kb, scr, lane); }
    }
    __syncthreads();
    LAS float* wbg = (LAS float*)lds;
    {   float tmpw[32];
#pragma unroll
        for (int i = 0; i < 32; ++i) { const int idx = tid + 512 * i, k = idx >> 4, c = idx & 15; tmpw[i] = w_in[(size_t)k * PW + 4096 + c]; }
#pragma unroll
        for (int i = 0; i < 32; ++i) { const int idx = tid + 512 * i, k = idx >> 4, c = idx & 15; wbg[c * 1024 + k] = tmpw[i]; } }
    __syncthreads();
    const LAS f32x4* wb4 = (const LAS f32x4*)wbg;
    f32x4 nw[4];
#pragma unroll
    for (int j = 0; j < 4; ++j) nw[j] = ((const f32x4*)norm_w)[lane + 64 * j];
    for (int m0 = gw; m0 < M; m0 += 4 * NGW) {
        int mr[4];
#pragma unroll
        for (int u = 0; u < 4; ++u) mr[u] = min(m0 + u * NGW, M - 1);
        if (m0 + 4 * NGW < M) P0_LOAD(vnx, m0 + 4 * NGW);
#pragma unroll
        for (int u = 0; u < 4; ++u) { float s = 0.f;
#pragma unroll
            for (int j = 0; j < 4; ++j) s += (vv[u][j].x * vv[u][j].x + vv[u][j].y * vv[u][j].y) + (vv[u][j].z * vv[u][j].z + vv[u][j].w * vv[u][j].w);
            const float rstd = __builtin_amdgcn_rsqf(wave_sum(s) * (1.f / D) + EPS);
            unsigned long long* o8 = (unsigned long long*)(HB + (size_t)mr[u] * D) + lane;
#pragma unroll
            for (int j = 0; j < 4; ++j) { vv[u][j] = vv[u][j] * rstd * nw[j];
                o8[64 * j] = (unsigned long long)cvt_pk_bf16(vv[u][j].x, vv[u][j].y) | ((unsigned long long)cvt_pk_bf16(vv[u][j].z, vv[u][j].w) << 32); } }
        float ds[64];
#pragma unroll
        for (int c = 0; c < 16; ++c) { f32x2 d2[4] = {{0.f, 0.f}, {0.f, 0.f}, {0.f, 0.f}, {0.f, 0.f}};
#pragma unroll
            for (int j = 0; j < 4; ++j) { const f32x4 w = wb4[c * 256 + lane + 64 * j]; const f32x2 w01 = {w.x, w.y}, w23 = {w.z, w.w};
#pragma unroll
                for (int u = 0; u < 4; ++u) { d2[u] = d2[u] + (f32x2){vv[u][j].x, vv[u][j].y} * w01; d2[u] = d2[u] + (f32x2){vv[u][j].z, vv[u][j].w} * w23; } }
#pragma unroll
            for (int u = 0; u < 4; ++u) ds[16 * u + c] = d2[u].x + d2[u].y; }
#pragma unroll
        for (int o = 32; o >= 1; o >>= 1) { const bool up = (lane & o) != 0;
#pragma unroll
            for (int k = 0; k < o; ++k) { const float lo = ds[k], hi = ds[k + o]; const float send = up ? lo : hi, keep = up ? hi : lo; ds[k] = keep + __shfl_xor(send, o); } }
        {   const float sel = ds[0]; const int u = lane >> 4, c = lane & 15; const int m = (u == 0) ? mr[0] : (u == 1 ? mr[1] : (u == 2 ? mr[2] : mr[3]));
            if (c < 8) Bb[(size_t)m * 8 + c] = 1.f / (1.f + expf(-sel));
            else { const int h = c - 8; const float xx = sel + dt_bias[h]; const float sp = fmaxf(xx, 0.f) + log1pf(expf(-fabsf(xx))); Gb[(size_t)m * 8 + h] = -expf(A_log[h]) * sp; } }
#pragma unroll
        for (int u = 0; u < 4; ++u)
#pragma unroll
            for (int j = 0; j < 4; ++j) vv[u][j] = vnx[u][j];
    }
#undef P0_LOAD
}

constexpr int KN_STRIDE = 136;
constexpr int AT_STRIDE = 68;
constexpr int PA_KN = 0, PA_QN = 64 * KN_STRIDE * 2, PA_AT = 2 * PA_QN, PA_VH = PA_AT + 64 * AT_STRIDE * 4, PA_SM = PA_VH + 64 * KN_STRIDE * 2, PA_ITEM_LDS = PA_SM + 1024;
static_assert(2 * PA_ITEM_LDS <= LDS_BYTES, "PA LDS");

DI void tri_solve(f32x2 (&X)[64], const LAS float* A) {
#ifdef DBG_NO_SOLVE
    return;
#endif
    const unsigned a_u = (unsigned)(size_t)A;
#pragma unroll
    for (int i = 1; i < 64; ++i) {
        unsigned ai = a_u + i * AT_STRIDE * 4;
        asm volatile("" : "+v"(ai) : "v"(X[(i < 32) ? (i >= 2 ? i - 2 : 0) : i - 1].x));
        const LAS float* rowp = (const LAS float*)ai;
        f32x2 acc[4] = {X[i], {0.f, 0.f}, {0.f, 0.f}, {0.f, 0.f}};
#pragma unroll
        for (int j4 = 0; 4 * j4 < i; ++j4) {
            const f32x4 av = *(const LAS f32x4*)(rowp + 4 * j4);
            acc[0] = acc[0] - X[4 * j4] * av.x;
            if (4 * j4 + 1 < i) acc[1] = acc[1] - X[4 * j4 + 1] * av.y;
            if (4 * j4 + 2 < i) acc[2] = acc[2] - X[4 * j4 + 2] * av.z;
            if (4 * j4 + 3 < i) acc[3] = acc[3] - X[4 * j4 + 3] * av.w;
        }
        X[i] = (acc[0] + acc[1]) + (acc[2] + acc[3]);
    }
}

DI void pa_phase(const Args& a, LAS unsigned char* lds, int G, int tid, int lane, int wave) {
    unsigned char* ws = a.ws;
    const float* conv_qkv_w = a.in[3];
    bf16* ACT = (bf16*)(ws + WS_ACT); const bf16* HALO = (const bf16*)(ws + WS_HALO); bf16* Wb = (bf16*)(ws + WS_HB);
    const float* Gb = (const float*)(ws + WS_G); const float* Bb = (const float*)(ws + WS_BETA); float* EGL = (float*)(ws + WS_EGL);
    bf16* ATTN = (bf16*)a.out;
    const int sg = wave >> 2, role = (wave & 3) ^ (sg << 1), tsg = tid & 255;
    LAS unsigned char* base = lds + sg * PA_ITEM_LDS;
    LAS unsigned char* KnB = base + PA_KN; LAS unsigned char* QnB = base + PA_QN; LAS unsigned char* ATB = base + PA_AT; LAS unsigned char* VhB = base + PA_VH;
    LAS bf16* Kn = (LAS bf16*)KnB; LAS bf16* Qn = (LAS bf16*)QnB; LAS float* AT = (LAS float*)ATB; LAS float* sm = (LAS float*)(base + PA_SM);
#ifdef DBG_NO_ITEMS
    const int nrounds = 0;
#else
    const int nrounds = (NITEM + 2 * G - 1) / (2 * G);
#endif
    for (int round = 0; round < nrounds; ++round) {
        int ln, tsl;
        const int item = (round * G + (int)blockIdx.x) * 2 + sg; const bool valid = item < NITEM;
        const int h = item & 7, c = (item >> 3) & 31, b = item >> 8; const size_t row0 = (size_t)b * T + (size_t)c * CH;
        ln = lane; tsl = tsg; asm volatile("" : "+v"(ln), "+v"(tsl));
        if (valid) {
            const int seg = tsl & 15, rr0 = tsl >> 4;
            const bf16* hb_ = HALO + ((size_t)(b * NCH + c - 1) * 3) * 3072 + h * HD + seg * 8;
            const bf16* gb_ = ACT + row0 * 1024 + h * HD + seg * 8;
#pragma unroll
            for (int tens = 0; tens < 3; ++tens) {
                LAS unsigned char* dreg = (tens == 0 ? QnB : (tens == 1 ? KnB : ATB)) + seg * 16;
                v4u v[5];
#pragma unroll
                for (int k = 0; k < 5; ++k) { const int rr = rr0 + 16 * k; v[k] = (v4u){0u, 0u, 0u, 0u};
                    if (rr < 67) { if (rr >= 3) v[k] = *(const v4u*)(gb_ + (size_t)tens * ACTSZ + (size_t)(rr - 3) * 1024); else if (c > 0) v[k] = *(const v4u*)(hb_ + (size_t)rr * 3072 + tens * 1024); } }
#pragma unroll
                for (int k = 0; k < 5; ++k) { const int rr = rr0 + 16 * k; if (rr < 67) *(LAS v4u*)(dreg + rr * 256) = v[k]; }
            }
        }
        __syncthreads();
        ln = lane; tsl = tsg; asm volatile("" : "+v"(ln), "+v"(tsl));
        if (valid && role < 3) {
            const int ti = (role == 0) ? 2 : (role == 1 ? 1 : 0);
            const LAS unsigned* rp = (const LAS unsigned*)(role == 0 ? ATB : (role == 1 ? KnB : QnB)) + ln;
            const float* cwp = conv_qkv_w + ti * 1024 + h * HD + 2 * ln;
            f32x2 cw[4];
#pragma unroll
            for (int j = 0; j < 4; ++j) { cw[j].x = cwp[j * 3072]; cw[j].y = cwp[j * 3072 + 1]; }
            f32x2 val[64];
            unsigned x0 = rp[0], x1 = rp[64], x2 = rp[128];
#pragma unroll
            for (int i = 0; i < 64; ++i) { const unsigned x3 = rp[(i + 3) * 64];
                f32x2 s;
                s.x = cw[0].x * bf_lo(x0) + cw[1].x * bf_lo(x1) + cw[2].x * bf_lo(x2) + cw[3].x * bf_lo(x3);
                s.y = cw[0].y * bf_hi(x0) + cw[1].y * bf_hi(x1) + cw[2].y * bf_hi(x2) + cw[3].y * bf_hi(x3);
#ifdef DBG_COPY_V
                val[i].x = bf_lo(x3); val[i].y = bf_hi(x3);
#else
                val[i].x = silu_f(s.x); val[i].y = silu_f(s.y);
#endif
                x0 = x1; x1 = x2; x2 = x3; }
            LAS unsigned* dst = (LAS unsigned*)(role == 0 ? VhB : (role == 1 ? KnB : QnB)) + ln;
            if (role != 0) {
                const float sc = (role == 2) ? 0.08838834764831845f : 1.f;
#pragma unroll
                for (int hb = 0; hb < 64; hb += 32) {
                    float ssq[32];
#pragma unroll
                    for (int i = 0; i < 32; ++i) ssq[i] = val[hb + i].x * val[hb + i].x + val[hb + i].y * val[hb + i].y;
#pragma unroll
                    for (int i = 0; i < 32; ++i) ssq[i] += DPP_MOV(ssq[i], 0xB1);
#pragma unroll
                    for (int i = 0; i < 32; ++i) ssq[i] += DPP_MOV(ssq[i], 0x4E);
#pragma unroll
                    for (int i = 0; i < 32; ++i) ssq[i] += DPP_MOV(ssq[i], 0x141);
#pragma unroll
                    for (int i = 0; i < 32; ++i) ssq[i] += DPP_MOV(ssq[i], 0x140);
#pragma unroll
                    for (int i = 0; i < 32; ++i) ssq[i] += DPP_UPD0(ssq[i], 0x142, 0xA);
#pragma unroll
                    for (int i = 0; i < 32; ++i) ssq[i] += DPP_UPD0(ssq[i], 0x143, 0xC);
#pragma unroll
                    for (int i = 0; i < 32; ++i) { const float tot = __int_as_float(__builtin_amdgcn_readlane(__float_as_int(ssq[i]), 63)); const float rs = sc * __builtin_amdgcn_rsqf(tot + EPS);
                        dst[(hb + i) * (KN_STRIDE / 2)] = cvt_pk_bf16(val[hb + i].x * rs, val[hb + i].y * rs); }
                    __builtin_amdgcn_sched_barrier(0);
                }
            } else {
#pragma unroll
                for (int i = 0; i < 64; ++i) dst[i * (KN_STRIDE / 2)] = cvt_pk_bf16(val[i].x, val[i].y);
            }
        } else if (valid) {
#ifdef DBG_CONST_GATES
            float v = -0.05f; const float bi = 0.5f;
#else
            float v = Gb[(row0 + ln) * 8 + h]; const float bi = Bb[(row0 + ln) * 8 + h];
#endif
#pragma unroll
            for (int o = 1; o < 64; o <<= 1) { const float t = __shfl_up(v, o); if (ln >= o) v += t; }
            const float gl = __shfl(v, 63);
            sm[ln] = v; sm[64 + ln] = bi; sm[128 + ln] = __expf(v); sm[192 + ln] = __expf(gl - v);
            if (ln == 63) EGL[item] = __expf(v);
        }
        __syncthreads();
        ln = lane; tsl = tsg; asm volatile("" : "+v"(ln), "+v"(tsl));
        if (valid) {
            const int r = ln & 15, q = ln >> 4, ti_ = role;
            LDSV(LAS float*, smv, sm); LDSV(LAS float*, ATv, AT); LDSV(LAS bf16*, Knv, Kn); LDSV(LAS bf16*, Qnv, Qn);
            bf16x8 ki[4], qi[4];
#pragma unroll
            for (int s = 0; s < 4; ++s) { ki[s] = *(const LAS bf16x8*)(Knv + (16 * ti_ + r) * KN_STRIDE + 32 * s + 8 * q); qi[s] = *(const LAS bf16x8*)(Qnv + (16 * ti_ + r) * KN_STRIDE + 32 * s + 8 * q); }
            bf16* attn_i = ATTN + (size_t)item * 4096 + (16 * ti_ + r) * 64 + 8 * q;
            const float gci2 = smv[16 * ti_ + r], bi2 = smv[64 + 16 * ti_ + r];
#pragma unroll
            for (int tj = 0; tj < 4; ++tj) {
                bf16* ap = attn_i + 32 * (tj >> 1) + 4 * (tj & 1);
                if (tj <= ti_) {
                    f32x4 c1 = {0.f, 0.f, 0.f, 0.f}, c2 = {0.f, 0.f, 0.f, 0.f};
#pragma unroll
                    for (int s = 0; s < 4; ++s) { const bf16x8 kj = *(const LAS bf16x8*)(Knv + (16 * tj + r) * KN_STRIDE + 32 * s + 8 * q); c1 = MFMA16(kj, ki[s], c1); c2 = MFMA16(kj, qi[s], c2); }
                    const int i2 = 16 * ti_ + r; float p[4];
                    f32x4 o;
#pragma unroll
                    for (int e = 0; e < 4; ++e) { const int j2 = 16 * tj + 4 * q + e; o[e] = (j2 < i2) ? bi2 * __expf(gci2 - smv[j2]) * c1[e] : 0.f; }
                    { v2u na; na.x = cvt_pk_bf16(-o[0], -o[1]); na.y = cvt_pk_bf16(-o[2], -o[3]); *(LAS v2u*)((LAS unsigned char*)ATv + i2 * 144 + (16 * tj + 4 * q) * 2) = na; }
                    if (tj == ti_) *(LAS f32x4*)((LAS unsigned char*)ATv + 9216 + ((ti_ * 16 + r) * 16 + 4 * q) * 4) = o;
#pragma unroll
                    for (int e = 0; e < 4; ++e) { const int j2 = 16 * tj + 4 * q + e; p[e] = (j2 <= i2) ? __expf(gci2 - smv[j2]) * c2[e] : 0.f; }
                    v2u w; w.x = cvt_pk_bf16(p[0], p[1]); w.y = cvt_pk_bf16(p[2], p[3]); *(v2u*)ap = w;
                } else { v2u w; w.x = 0u; w.y = 0u; *(v2u*)ap = w; }
            }
        }
        __syncthreads();
        ln = lane; tsl = tsg; asm volatile("" : "+v"(ln), "+v"(tsl));
        if (valid) {
            LDSV(LAS float*, smv, sm); LDSV(LAS unsigned char*, QnBv, QnB); LDSV(LAS bf16*, Knv, Kn);
            for (int pc = tsl; pc < 1024; pc += 256) {
                const int i = pc >> 4, sg8 = pc & 15, s = sg8 >> 2, q = sg8 & 3; const float e = smv[128 + i];
                const v2u lo = *(const LAS v2u*)(QnBv + i * 272 + (32 * s + 4 * q) * 2), hi = *(const LAS v2u*)(QnBv + i * 272 + (32 * s + 16 + 4 * q) * 2);
                v4u o; o.x = cvt_pk_bf16(bf_lo(lo.x) * e, bf_hi(lo.x) * e); o.y = cvt_pk_bf16(bf_lo(lo.y) * e, bf_hi(lo.y) * e); o.z = cvt_pk_bf16(bf_lo(hi.x) * e, bf_hi(hi.x) * e); o.w = cvt_pk_bf16(bf_lo(hi.y) * e, bf_hi(hi.y) * e);
                *(v4u*)(ACT + (row0 + i) * 1024 + h * HD + sg8 * 8) = o; }
            for (int pc = tsl; pc < 1024; pc += 256) {
                const int dk = pc >> 3, g = pc & 7, s = g >> 2, q = g & 3; float f[8];
#pragma unroll
                for (int e = 0; e < 8; ++e) { const int j = 32 * s + 16 * (e >> 2) + 4 * q + (e & 3); f[e] = __uint_as_float((unsigned)Knv[j * KN_STRIDE + dk] << 16) * smv[192 + j]; }
                v4u o; o.x = cvt_pk_bf16(f[0], f[1]); o.y = cvt_pk_bf16(f[2], f[3]); o.z = cvt_pk_bf16(f[4], f[5]); o.w = cvt_pk_bf16(f[6], f[7]);
                *(v4u*)(ACT + ACTSZ + (row0 + (dk >> 1)) * 1024 + h * HD + (dk & 1) * 64 + g * 8) = o; }
        }
        __syncthreads();
        ln = lane; tsl = tsg; asm volatile("" : "+v"(ln), "+v"(tsl));
        f32x4 Rv[4][4];
        const int cbase = 64 * (role & 1);
        if (valid) {
            LDSV(LAS float*, smv, sm);
            const int r = ln & 15, q = ln >> 4;
            const LAS bf16* tile = (const LAS bf16*)(role < 2 ? VhB : KnB);
#pragma unroll
            for (int bb = 0; bb < 4; ++bb)
#pragma unroll
                for (int e = 0; e < 4; ++e) { const int row = 16 * bb + 4 * q + e; const float be = smv[64 + row], eg = smv[128 + row]; const float f = (role < 2) ? be : be * eg;
#pragma unroll
                    for (int nt = 0; nt < 4; ++nt) Rv[nt][bb][e] = __uint_as_float((unsigned)tile[row * KN_STRIDE + cbase + 16 * nt + r] << 16) * f; }
        }
        __syncthreads();
        ln = lane; tsl = tsg; asm volatile("" : "+v"(ln), "+v"(tsl));
        if (valid) {
            LAS unsigned char* XT = (role < 2 ? VhB : KnB);
            {   LAS unsigned char* zp = XT + cbase * 136 + ln * 16;
                const v4u z4 = {0u, 0u, 0u, 0u};
#pragma unroll
                for (int k = 0; k < 8; ++k) *(LAS v4u*)(zp + 1024 * k) = z4;
                if (ln < 32) *(LAS v4u*)(zp + 8192) = z4; }
            if (role == 0) {
                LDSV(LAS unsigned char*, ATu, ATB);
                const int tb = ln >> 4, tc = ln & 15;
                const LAS float* adg = (const LAS float*)(ATu + 9216) + tb * 256;
                float t[16];
#pragma unroll
                for (int i = 0; i < 16; ++i) { float acc = (tc == i) ? 1.f : 0.f;
#pragma unroll
                    for (int j4 = 0; 4 * j4 < i; ++j4) { const f32x4 av = *(const LAS f32x4*)(adg + i * 16 + 4 * j4);
                        acc -= av.x * t[4 * j4]; if (4 * j4 + 1 < i) acc -= av.y * t[4 * j4 + 1]; if (4 * j4 + 2 < i) acc -= av.z * t[4 * j4 + 2]; if (4 * j4 + 3 < i) acc -= av.w * t[4 * j4 + 3]; }
                    t[i] = acc; }
                LAS unsigned char* tp = ATu + 13312 + tb * 1024 + (8 * (tc >> 2) + (tc & 3)) * 2;
#pragma unroll
                for (int i = 0; i < 16; ++i) { const float to = DPP_MOV(t[i], 0xB1);
                    if ((tc & 1) == 0) *(LAS unsigned*)(tp + i * 64) = cvt_pk_bf16(t[i], to);
                    if ((tc & 3) == 0) { v2u z2; z2.x = 0u; z2.y = 0u; *(LAS v2u*)(tp + i * 64 + 8) = z2; } }
            }
        }
        __syncthreads();
        ln = lane; tsl = tsg; asm volatile("" : "+v"(ln), "+v"(tsl));
        if (valid) {
            LDSV(LAS unsigned char*, ATu, ATB);
            LAS unsigned char* XT = (role < 2 ? VhB : KnB);
            const int r = ln & 15, q = ln >> 4;
            LAS unsigned char* xcol = XT + (cbase + r) * 136;
#pragma unroll
            for (int bb = 0; bb < 4; ++bb) {
                const bf16x8 tf = *(const LAS bf16x8*)(ATu + 13312 + ((bb * 16 + r) * 32 + 8 * q) * 2);
                bf16x8 af[2];
#pragma unroll
                for (int ks = 0; ks < 2; ++ks) if (32 * ks < 16 * bb) af[ks] = *(const LAS bf16x8*)(ATu + (16 * bb + r) * 144 + (32 * ks + 8 * q) * 2);
#pragma unroll
                for (int nt = 0; nt < 4; ++nt) {
                    f32x4 acc = Rv[nt][bb];
#pragma unroll
                    for (int ks = 0; ks < 2; ++ks) if (32 * ks < 16 * bb) {
                        const v2u lo = *(const LAS v2u*)(xcol + nt * (16 * 136) + (32 * ks + 8 * q) * 2), hi = *(const LAS v2u*)(xcol + nt * (16 * 136) + (32 * ks + 8 * q) * 2 + 8);
                        v4u bw; bw.x = lo.x; bw.y = lo.y; bw.z = hi.x; bw.w = hi.y;
                        acc = MFMA16(af[ks], __builtin_bit_cast(bf16x8, bw), acc); }
                    v4u rw; rw.x = cvt_pk_bf16_v(acc[0], acc[1]); rw.y = cvt_pk_bf16_v(acc[2], acc[3]); rw.z = 0u; rw.w = 0u;
                    const f32x4 zero4 = {0.f, 0.f, 0.f, 0.f};
                    const f32x4 x = MFMA16(tf, __builtin_bit_cast(bf16x8, rw), zero4);
                    v2u xw; xw.x = cvt_pk_bf16_v(x[0], x[1]); xw.y = cvt_pk_bf16_v(x[2], x[3]);
                    *(LAS v2u*)(xcol + nt * (16 * 136) + (16 * bb + 4 * q) * 2) = xw;
                }
            }
        }
        __syncthreads();
        ln = lane; tsl = tsg; asm volatile("" : "+v"(ln), "+v"(tsl));
        if (valid) {
            for (int pc = tsl; pc < 2048; pc += 256) { const int which = pc >> 10, id = pc & 1023, i = id & 63, seg = id >> 6;
                const LAS bf16* xt = (const LAS bf16*)(which ? KnB : VhB) + i;
                unsigned short v[8];
#pragma unroll
                for (int e = 0; e < 8; ++e) { const int p = seg * 8 + e; const int col = which ? ((p & ~31) | (((p >> 2) & 1) << 4) | (((p >> 3) & 3) << 2) | (p & 3)) : p; v[e] = xt[col * 68]; }
                v4u o; o.x = (unsigned)v[0] | ((unsigned)v[1] << 16); o.y = (unsigned)v[2] | ((unsigned)v[3] << 16); o.z = (unsigned)v[4] | ((unsigned)v[5] << 16); o.w = (unsigned)v[6] | ((unsigned)v[7] << 16);
                bf16* dstp = which ? (Wb + (row0 + i) * 1024 + h * HD + seg * 8) : (ACT + 2 * ACTSZ + (row0 + i) * 1024 + h * HD + seg * 8);
                *(v4u*)dstp = o; }
        }
        __syncthreads();
    }
}

DI void yc_phase(const Args& a, int first, int G, int tid) {
    unsigned char* ws = a.ws; bf16* ACT = (bf16*)(ws + WS_ACT);
    {
        const float* conv_w = a.in[7]; const float* conv_b = a.in[8];
        const bf16* Pb = ACT + 4 * ACTSZ; bf16* Sb = ACT + 5 * ACTSZ;
        const int cgp = tid & 127, rq = tid >> 7, col = cgp * 8;
        float w0[8], w1[8], w2[8], bb[8];
#pragma unroll
        for (int e = 0; e < 8; ++e) { w0[e] = conv_w[col + e]; w1[e] = conv_w[1024 + col + e]; w2[e] = conv_w[2048 + col + e]; bb[e] = conv_b[col + e]; }
        for (int rc = (int)blockIdx.x - first; rc < M / 64; rc += G - first) {
            const size_t r0 = (size_t)rc * 64 + rq * 16;
            v4u pm2 = {0u, 0u, 0u, 0u}, pm1 = {0u, 0u, 0u, 0u};
            if ((r0 & (T - 1)) != 0) { pm2 = *(const v4u*)(Pb + (r0 - 2) * 1024 + col); pm1 = *(const v4u*)(Pb + (r0 - 1) * 1024 + col); }
#pragma unroll 4
            for (int i = 0; i < 16; ++i) {
                const v4u p0 = *(const v4u*)(Pb + (r0 + i) * 1024 + col); const v4u sv = *(const v4u*)(Sb + (r0 + i) * 1024 + col);
                v4u o;
#pragma unroll
                for (int e = 0; e < 4; ++e) {
                    const float ylo = bf_lo(sv[e]) * (w0[2 * e] * bf_lo(pm2[e]) + w1[2 * e] * bf_lo(pm1[e]) + w2[2 * e] * bf_lo(p0[e]) + bb[2 * e]);
                    const float yhi = bf_hi(sv[e]) * (w0[2 * e + 1] * bf_hi(pm2[e]) + w1[2 * e + 1] * bf_hi(pm1[e]) + w2[2 * e + 1] * bf_hi(p0[e]) + bb[2 * e + 1]);
                    o[e] = cvt_pk_bf16(ylo, yhi); }
                *(v4u*)(Sb + (r0 + i) * 1024 + col) = o;
                pm2 = pm1; pm1 = p0;
            }
        }
    }
}

constexpr int PB_W = 0, PB_Q = 64 * 272, PB_K = 2 * 64 * 272, PB_A = 3 * 64 * 272, PB_U = PB_A + 64 * 144, PB_BUF = PB_U + 64 * 144;
static_assert(2 * PB_BUF <= LDS_BYTES - 16, "PB LDS");
DI void pb_phase(const Args& a, LAS unsigned char* lds, int vcu, int G, int tid, int lane, int wave) {
    unsigned char* ws = a.ws;
    bf16* ACT = (bf16*)(ws + WS_ACT); const bf16* Wb = (const bf16*)(ws + WS_HB); const float* EGL = (const float*)(ws + WS_EGL);
    const bf16* ATTN = (const bf16*)a.out;
    const int r = lane & 15, q = lane >> 4;
    for (int unit = blockIdx.x; unit < 2 * BATCH * NH; unit += G) {
        const int half = (unit >> 3) & 1, bh = (unit & 7) + 8 * (unit >> 4), h = bh & 7, b = bh >> 3;
        if (wave >= 4) {
            const int tl = tid - 256;
            v4u st[16];
#define PB_ISSUE(c_) do { const size_t row0_ = (size_t)b * T + (size_t)(c_) * CH; const int item_ = (b * NCH + (c_)) * NH + h; \
                _Pragma("unroll") for (int k = 0; k < 12; ++k) { const int p = tl + 256 * (k & 3), rw = p >> 4, sg_ = p & 15; \
                    const bf16* src = (k < 4 ? Wb : (k < 8 ? (const bf16*)ACT : (const bf16*)(ACT + ACTSZ))) + (row0_ + rw) * 1024 + h * HD + sg_ * 8; st[k] = *(const v4u*)src; } \
                _Pragma("unroll") for (int k = 12; k < 14; ++k) { const int p = tl + 256 * (k - 12); st[k] = *(const v4u*)(ATTN + (size_t)item_ * 4096 + (p >> 3) * 64 + (p & 7) * 8); } \
                _Pragma("unroll") for (int k = 14; k < 16; ++k) { const int p = tl + 256 * (k - 14); st[k] = *(const v4u*)(ACT + 2 * ACTSZ + (row0_ + (p >> 3)) * 1024 + h * HD + 64 * half + (p & 7) * 8); } } while (0)
#define PB_COMMIT(buf_) do { LAS unsigned char* bb_ = lds + (buf_) * PB_BUF; \
                _Pragma("unroll") for (int k = 0; k < 12; ++k) { const int p = tl + 256 * (k & 3), rw = p >> 4, sg_ = p & 15; *(LAS v4u*)(bb_ + (k >> 2) * (64 * 272) + rw * 272 + sg_ * 16) = st[k]; } \
                _Pragma("unroll") for (int k = 12; k < 14; ++k) { const int p = tl + 256 * (k - 12); *(LAS v4u*)(bb_ + PB_A + (p >> 3) * 144 + (p & 7) * 16) = st[k]; } \
                _Pragma("unroll") for (int k = 14; k < 16; ++k) { const int p = tl + 256 * (k - 14); *(LAS v4u*)(bb_ + PB_U + (p >> 3) * 144 + (p & 7) * 16) = st[k]; } } while (0)
            PB_ISSUE(0); PB_COMMIT(0); PB_ISSUE(1);
            __syncthreads();
            for (int c = 0; c < NCH; ++c) {
                if (c + 1 < NCH) PB_COMMIT((c + 1) & 1);
                if (c + 2 < NCH) PB_ISSUE(c + 2);
                __syncthreads();
            }
#undef PB_ISSUE
#undef PB_COMMIT
        } else {
            const int sl = 4 * half + wave;
            const float eglv = (lane < NCH) ? EGL[(b * NCH + lane) * NH + h] : 0.f;
            f32x4 S[8];
#pragma unroll
            for (int tm = 0; tm < 8; ++tm) S[tm] = (f32x4){0.f, 0.f, 0.f, 0.f};
            __syncthreads();
            for (int c = 0; c < NCH; ++c) {
                const size_t row0 = (size_t)b * T + (size_t)c * CH; const int item = (b * NCH + c) * NH + h;
                const LAS unsigned char* bb = lds + (c & 1) * PB_BUF;
                const LAS unsigned char* wp = bb + PB_W + r * 272 + q * 16;
                const LAS unsigned char* qp = bb + PB_Q + r * 272 + q * 16;
                const LAS unsigned char* kp = bb + PB_K + (r >> 1) * 272 + (r & 1) * 128 + q * 16;
                const LAS unsigned char* ap = bb + PB_A + r * 144 + q * 16;
                const LAS bf16* uq = (const LAS bf16*)(bb + PB_U + (4 * q) * 144) + 16 * wave + r;
                const float egl = __int_as_float(__builtin_amdgcn_readlane(__float_as_int(eglv), c));
                bf16x8 Sb[4];
#pragma unroll
                for (int s = 0; s < 4; ++s) { v4u w; w.x = cvt_pk_bf16_v(S[2 * s][0], S[2 * s][1]); w.y = cvt_pk_bf16_v(S[2 * s][2], S[2 * s][3]); w.z = cvt_pk_bf16_v(S[2 * s + 1][0], S[2 * s + 1][1]); w.w = cvt_pk_bf16_v(S[2 * s + 1][2], S[2 * s + 1][3]);
                    Sb[s] = __builtin_bit_cast(bf16x8, w); }
                f32x4 vn[4], O[4];
#pragma unroll
                for (int t = 0; t < 4; ++t) {
                    f32x4 p = {0.f, 0.f, 0.f, 0.f}, o = {0.f, 0.f, 0.f, 0.f};
#pragma unroll
                    for (int s = 0; s < 4; ++s) { const bf16x8 wf = *(const LAS bf16x8*)(wp + t * (16 * 272) + s * 64); const bf16x8 qf = *(const LAS bf16x8*)(qp + t * (16 * 272) + s * 64);
                        p = MFMA16(wf, Sb[s], p); o = MFMA16(qf, Sb[s], o); }
#pragma unroll
                    for (int e = 0; e < 4; ++e) vn[t][e] = __uint_as_float((unsigned)uq[(16 * t + e) * 72] << 16) - p[e];
                    O[t] = o;
                }
                bf16x8 vb[2];
#pragma unroll
                for (int s = 0; s < 2; ++s) { v4u w; w.x = cvt_pk_bf16_v(vn[2 * s][0], vn[2 * s][1]); w.y = cvt_pk_bf16_v(vn[2 * s][2], vn[2 * s][3]); w.z = cvt_pk_bf16_v(vn[2 * s + 1][0], vn[2 * s + 1][1]); w.w = cvt_pk_bf16_v(vn[2 * s + 1][2], vn[2 * s + 1][3]);
                    vb[s] = __builtin_bit_cast(bf16x8, w); }
#pragma unroll
                for (int t = 0; t < 4; ++t) {
#pragma unroll
                    for (int s = 0; s < 2; ++s) { const bf16x8 af = *(const LAS bf16x8*)(ap + t * (16 * 144) + s * 64); O[t] = MFMA16(af, vb[s], O[t]); }
                }
#pragma unroll
                for (int tm = 0; tm < 8; ++tm) {
                    f32x4 acc = S[tm] * egl;
#pragma unroll
                    for (int s = 0; s < 2; ++s) { const bf16x8 kf = *(const LAS bf16x8*)(kp + tm * (8 * 272) + s * 64); acc = MFMA16(kf, vb[s], acc); }
                    S[tm] = acc;
                }
                bf16* up = ACT + 2 * ACTSZ + (row0 + 4 * q) * 1024 + h * HD + 16 * sl + r;
#pragma unroll
                for (int t = 0; t < 4; ++t)
#pragma unroll
                    for (int e = 0; e < 4; ++e) up[(size_t)(16 * t + e) * 1024] = (bf16)(cvt_pk_bf16_v(O[t][e], 0.f) & 0xffffu);
                __syncthreads();
            }
        }
    }
}

DI void pg_phase(const Args& a, int G, int tid) {
    unsigned char* ws = a.ws; const float* gw = a.in[6];
    bf16* ACT = (bf16*)(ws + WS_ACT); bf16* Ob = ACT + 2 * ACTSZ; const bf16* Zb = ACT + 3 * ACTSZ;
    const size_t total = (size_t)M * 128, stride = (size_t)G * 512;
    const int dv0 = (tid & 15) * 8;
    const f32x4 g0 = *(const f32x4*)(gw + dv0), g1 = *(const f32x4*)(gw + dv0 + 4);
    const float gg[8] = {g0.x, g0.y, g0.z, g0.w, g1.x, g1.y, g1.z, g1.w};
    for (size_t base = (size_t)blockIdx.x * 512 + tid; base < total; base += 8 * stride) {
        v4u ov[8], zv[8];
#pragma unroll
        for (int u = 0; u < 8; ++u) { const size_t idx = base + u * stride; if (idx < total) { const size_t m = idx >> 7; const int cgp = (int)(idx & 127);
            ov[u] = *(const v4u*)(Ob + m * 1024 + cgp * 8); zv[u] = *(const v4u*)(Zb + m * 1024 + cgp * 8); } }
#pragma unroll
        for (int u = 0; u < 8; ++u) { const size_t idx = base + u * stride; if (idx < total) { const size_t m = idx >> 7; const int cgp = (int)(idx & 127);
            float of[8], ss = 0.f;
#pragma unroll
            for (int e = 0; e < 4; ++e) { of[2 * e] = bf_lo(ov[u][e]); of[2 * e + 1] = bf_hi(ov[u][e]); ss += of[2 * e] * of[2 * e] + of[2 * e + 1] * of[2 * e + 1]; }
            ss = row16_sum(ss);
            const float rstd = __builtin_amdgcn_rsqf(ss * (1.f / HD) + EPS);
            v4u o;
#pragma unroll
            for (int e = 0; e < 4; ++e) o[e] = cvt_pk_bf16(of[2 * e] * rstd * gg[2 * e] * bf_lo(zv[u][e]), of[2 * e + 1] * rstd * gg[2 * e + 1] * bf_hi(zv[u][e]));
            *(v4u*)(Ob + m * 1024 + cgp * 8) = o; } }
    }
}

DI void p6_phase(const Args& a, int vcu, int G, int lane, int wave) {
    const float* fw = a.in[10];
    const int gw = vcu * NWAVES + wave, NGW = G * NWAVES;
    f32x4 w[4];
#pragma unroll
    for (int j = 0; j < 4; ++j) w[j] = ((const f32x4*)fw)[lane + 64 * j];
    for (int m = gw; m < M; m += 4 * NGW) {
        f32x4 v[4][4];
#pragma unroll
        for (int u = 0; u < 4; ++u) { const int mm = m + u * NGW; if (mm < M) { const f32x4* yr = (const f32x4*)(a.out + (size_t)mm * D) + lane;
#pragma unroll
            for (int j = 0; j < 4; ++j) v[u][j] = yr[64 * j]; } }
#pragma unroll
        for (int u = 0; u < 4; ++u) { const int mm = m + u * NGW; if (mm < M) { f32x4* yr = (f32x4*)(a.out + (size_t)mm * D) + lane; float s = 0.f;
#pragma unroll
            for (int j = 0; j < 4; ++j) s += (v[u][j].x * v[u][j].x + v[u][j].y * v[u][j].y) + (v[u][j].z * v[u][j].z + v[u][j].w * v[u][j].w);
            const float rstd = 1.f / sqrtf(wave_sum(s) * (1.f / D) + EPS);
#pragma unroll
            for (int j = 0; j < 4; ++j) yr[64 * j] = v[u][j] * rstd * w[j]; } }
    }
}

#ifndef MK_SKIP_GDN
#define MK_SKIP_GDN 0
#endif
__global__ void __launch_bounds__(NWAVES * 64, 2) hybrid_fwd(Args args) {
    extern __shared__ __attribute__((aligned(16))) unsigned char lds_raw[];
    cg::grid_group grid = cg::this_grid();
    LAS unsigned char* lds = (LAS unsigned char*)lds_raw;
    const int tid = threadIdx.x, lane = tid & 63, wave = __builtin_amdgcn_readfirstlane(tid >> 6);
    const int G = gridDim.x, bx = blockIdx.x;
    const int vcu = (G % 8 == 0) ? (bx % 8) * (G / 8) + bx / 8 : bx;
    unsigned char* ws = args.ws;
    bf16* ACT = (bf16*)(ws + WS_ACT);

    volatile LAS unsigned* xst = (volatile LAS unsigned*)(lds + LDS_BYTES - 16);
    if (tid < 4) xst[tid] = 0u;
    __syncthreads();
    if (bx == 0) for (int i = tid; i < XCD_BAR_WORDS; i += NWAVES * 64) ((unsigned*)ws)[i] = 0u;
#ifndef NO_P0
    p0_prologue(args, lds, vcu, G, tid, lane, wave);
#endif
    if (bx == 0 && tid < 64) ((unsigned*)(ws + WS_EGL + 32768))[16 * tid] = 0u;
#ifdef PROBE_P0X2
    __syncthreads();
    p0_prologue(args, lds, vcu, G, tid, lane, wave);
#endif
    grid.sync();
    XcdBarrier xbar = xcd_barrier_post((unsigned*)ws, xst);
    {
        pg8::Gemm g{(const bf16*)(ws + WS_HB), (const bf16*)(ws + WS_WIN), M, N1, D, D, D / 64, 0};
        pg8::StaticOrder S; S.init(M, N1, G, bx);
        pg8::EpiProj E{ACT, (bf16*)(ws + WS_HALO), ACTSZ};
        pg8::gemm_phase<pg8::EpiProj, pg8::StaticOrder, true, true>(lds, g, S, E);
#ifdef PROBE_P1X2
        pg8::gemm_phase<pg8::EpiProj, pg8::StaticOrder, true, true>(lds, g, S, E);
#endif
    }
    xcd_barrier(xbar);
#ifndef NO_PA
    pa_phase(args, lds, G, tid, lane, wave);
#endif
    xcd_barrier(xbar);
#ifndef NO_PB
    pb_phase(args, lds, vcu, G, tid, lane, wave);
#endif
    if (G > 2 * BATCH * NH) { if (bx >= 2 * BATCH * NH) yc_phase(args, 2 * BATCH * NH, G, tid); } else yc_phase(args, 0, G, tid);
    xcd_barrier(xbar);
    pg_phase(args, G, tid);
    xcd_barrier(xbar);
    {
        pg8::Gemm g{ACT + 2 * ACTSZ, (const bf16*)(ws + WS_WOUT), M, D, KMIX, 1024, 16, (long)(3 * ACTSZ * 2)};
        pg8::StaticOrder S; S.init(M, D, G, bx);
        if (G == 256) {
            pg8::EpiResNorm E{args.in[0], args.out, args.in[10], (float*)(ws + WS_SSQ), (unsigned*)(ws + WS_EGL + 32768), D, EPS};
            pg8::gemm_phase<pg8::EpiResNorm, pg8::StaticOrder, false, true>(lds, g, S, E);
        } else {
            pg8::EpiRes E{args.in[0], args.out, D};
            pg8::gemm_phase<pg8::EpiRes, pg8::StaticOrder, true, true>(lds, g, S, E);
            grid.sync();
            p6_phase(args, vcu, G, lane, wave);
        }
    }
}

extern "C" void kernel_launch(void* const* d_in, const int* in_sizes, int n_in, void* d_out, int out_size, void* d_ws, size_t ws_size, hipStream_t stream) {
    static int grid = 0;
    if (grid == 0) {
        if (n_in != 11 || in_sizes[0] != M * D || out_size != M * D || ws_size < WS_END) { fprintf(stderr, "kernel_launch: unexpected shapes (n_in %d, in0 %d, out %d, ws %zu)\n", n_in, n_in > 0 ? in_sizes[0] : -1, out_size, ws_size); grid = -1; return; }
        int dev = 0, cus = 0, per_cu = 0;
        if (hipGetDevice(&dev) != hipSuccess || hipDeviceGetAttribute(&cus, hipDeviceAttributeMultiprocessorCount, dev) != hipSuccess) { grid = -1; return; }
        if (hipFuncSetAttribute((const void*)hybrid_fwd, hipFuncAttributeMaxDynamicSharedMemorySize, LDS_BYTES) != hipSuccess) { fprintf(stderr, "kernel_launch: hipFuncSetAttribute failed\n"); grid = -1; return; }
        if (hipOccupancyMaxActiveBlocksPerMultiprocessor(&per_cu, (const void*)hybrid_fwd, NWAVES * 64, LDS_BYTES) != hipSuccess || per_cu < 1) { fprintf(stderr, "kernel_launch: occupancy query gave %d\n", per_cu); (void)hipGetLastError(); per_cu = 1; }
        grid = cus * 1;
        if (grid > cus * per_cu) grid = cus * per_cu;
    }
    if (grid < 0) return;
    Args a{};
    for (int i = 0; i < 11; ++i) a.in[i] = (const float*)d_in[i];
    a.out = (float*)d_out; a.ws = (unsigned char*)d_ws;
    void* kargs[] = {&a};
    hipError_t e = hipLaunchCooperativeKernel((const void*)hybrid_fwd, dim3(grid), dim3(NWAVES * 64), kargs, LDS_BYTES, stream);
    if (e != hipSuccess) fprintf(stderr, "kernel_launch: cooperative launch failed: %s (grid %d)\n", hipGetErrorString(e), grid);
}
```

```cpp
#include <hip/hip_runtime.h>
#include <hip/hip_cooperative_groups.h>
#include <cstdio>
#include <cstdint>
namespace cg = cooperative_groups;
namespace pg8 {
#define PG8_LAS __attribute__((address_space(3)))
typedef unsigned short bf16_t;
typedef short bf16x8 __attribute__((ext_vector_type(8)));
typedef float f32x4 __attribute__((ext_vector_type(4)));
typedef unsigned u32x4 __attribute__((ext_vector_type(4)));
constexpr int BM = 256, BK = 64, HALF = 128, HTB = HALF * BK * 2  , STAGE_BYTES = 8 * HTB, NXCD = 8, WGM = 8;

__host__ __device__ __forceinline__ int lds_byte(int r, int c) { const int st = (r >> 4) * 2 + (c >> 5), rr = r & 15, cc = c & 31, ob = rr * 64 + cc * 2; return st * 1024 + (ob ^ (((ob >> 9) & 1) << 5)); }
__host__ __device__ __forceinline__ void stage_rc(int b, int& R, int& C) { const int st = b / 1024, sb = b % 1024, swz = sb ^ (((sb >> 9) & 1) << 5); R = (st >> 1) * 16 + swz / 64; C = (st & 1) * 32 + (swz % 64) / 2; }
__host__ __device__ __forceinline__ int perm32(int rho) { const int n = rho >> 4, i = rho & 15; return 8 * (i >> 2) + 4 * n + (i & 3); }

struct Unit { int pm, pn; };
struct Gemm { const bf16_t* A; const bf16_t* Bt; int M, N, K, lda, ksplit; long a2off; };

struct StaticOrder {
    int nM, nN, nwg, G, c;
    __host__ __device__ void init(int M, int N, int G_, int c_) { nM = M / BM; nN = N / BM; nwg = nM * nN; G = G_; c = c_; }
    __host__ __device__ bool next(int i, Unit& u) const {
        const long L = (long)i * G + c; if (L >= nwg) return false;
        int wgid = (int)L; { const int q = nwg / NXCD, r = nwg % NXCD, xcd = wgid % NXCD, off = wgid / NXCD; wgid = (xcd < r ? xcd * (q + 1) : r * (q + 1) + (xcd - r) * q) + off; }
        const int nig = WGM * nN, gid = wgid / nig, fm = gid * WGM, gsz = (nM - fm) < WGM ? (nM - fm) : WGM;
        u.pm = fm + ((wgid % nig) % gsz); u.pn = (wgid % nig) / gsz; return true;
    }
    __device__ __forceinline__ void a_ready(const Unit&) const {}
    __device__ __forceinline__ void done(const Unit&) const {}
};


typedef float f32x2_cv __attribute__((ext_vector_type(2)));
typedef __bf16 bf16x2_cv __attribute__((ext_vector_type(2)));
__device__ __forceinline__ unsigned cvt_pk_bf16_v(float lo, float hi) { f32x2_cv v = {lo, hi}; bf16x2_cv r = __builtin_convertvector(v, bf16x2_cv); return __builtin_bit_cast(unsigned, r); }
__device__ __forceinline__ unsigned cvt_pk_bf16(float lo, float hi) { unsigned r; asm volatile("v_cvt_pk_bf16_f32 %0, %1, %2" : "=v"(r) : "v"(lo), "v"(hi)); return r; }
__device__ __forceinline__ float silu_f(float x) { return x * __builtin_amdgcn_rcpf(1.f + __expf(-x)); }

struct EpiProj {
    static constexpr bool PERM = true, AFTER_DRAIN = false;
    bf16_t* ACT; bf16_t* HALO; size_t actsz;
    __device__ __forceinline__ void operator()(const f32x4 (&acc)[2][2][4][2], const Unit& u, int wr, int wc, int fr, int fq) const {
        const int pn = u.pn, row0 = u.pm * BM + wr * 64 + fr, cw = wc * 32 + 8 * fq;
        if (pn < 16) {
            bf16_t* base = ACT + (size_t)(pn >> 2) * actsz + (pn & 3) * 256 + cw;
            const bool act = pn >= 12, halo = pn < 12;
#pragma unroll
            for (int ai = 0; ai < 2; ++ai)
#pragma unroll
                for (int m = 0; m < 4; ++m) { const int row = row0 + ai * HALF + m * 16; bf16_t* rowp = base + (size_t)row * 1024;
#pragma unroll
                    for (int bj = 0; bj < 2; ++bj) { f32x4 v0 = acc[ai][bj][m][0], v1 = acc[ai][bj][m][1];
                        if (act) {
#pragma unroll
                            for (int j = 0; j < 4; ++j) { v0[j] = silu_f(v0[j]); v1[j] = silu_f(v1[j]); } }
                        u32x4 w; w.x = cvt_pk_bf16_v(v0[0], v0[1]); w.y = cvt_pk_bf16_v(v0[2], v0[3]); w.z = cvt_pk_bf16_v(v1[0], v1[1]); w.w = cvt_pk_bf16_v(v1[2], v1[3]);
                        *(u32x4*)(rowp + bj * HALF) = w;
                        if (m == 3 && halo && fr >= 13) *(u32x4*)(HALO + ((size_t)(row >> 6) * 3 + (fr - 13)) * 3072 + pn * 256 + bj * HALF + cw) = w; } }
        } else {
            const bool kind = pn >= 24; bf16_t* base = ACT + (size_t)(kind ? 5 : 4) * actsz + ((pn - 16) & 7) * 128 + cw;
#pragma unroll
            for (int ai = 0; ai < 2; ++ai)
#pragma unroll
                for (int m = 0; m < 4; ++m) { const int row = row0 + ai * HALF + m * 16;
                    f32x4 a0 = acc[ai][0][m][0], a1 = acc[ai][0][m][1], b0 = acc[ai][1][m][0], b1 = acc[ai][1][m][1];
                    if (kind) {
#pragma unroll
                        for (int j = 0; j < 4; ++j) { b0[j] = silu_f(b0[j]); b1[j] = silu_f(b1[j]); } }
                    a0 = a0 * b0; a1 = a1 * b1;
                    u32x4 w; w.x = cvt_pk_bf16(a0[0], a0[1]); w.y = cvt_pk_bf16(a0[2], a0[3]); w.z = cvt_pk_bf16(a1[0], a1[1]); w.w = cvt_pk_bf16(a1[2], a1[3]);
                    *(u32x4*)(base + (size_t)row * 1024) = w; }
        }
    }
};
struct EpiResNorm {
    static constexpr bool PERM = false, AFTER_DRAIN = true;
    const float* X; float* Y; const float* FW; float* part; unsigned* cnt; int ldc; float eps;
    __device__ __forceinline__ void operator()(const f32x4 (&)[2][2][4][2], const Unit&, int, int, int, int) const {}
    __device__ __forceinline__ void fused(const f32x4 (&acc)[2][2][4][2], const Unit& u, int wr, int wc, int fr, int fq, PG8_LAS unsigned char* lds, int wid, int lane) const {
        f32x4 (&yv)[2][2][4][2] = const_cast<f32x4 (&)[2][2][4][2]>(acc);
        PG8_LAS float* red = (PG8_LAS float*)lds;
        PG8_LAS float* rs = (PG8_LAS float*)(lds + 4096);
        const int row0 = u.pm * BM + wr * 64 + fr, col0 = u.pn * BM + wc * 32 + 4 * fq; int tid = threadIdx.x; asm volatile("" : "+v"(tid));
#pragma unroll
        for (int ai = 0; ai < 2; ++ai)
#pragma unroll
            for (int m = 0; m < 4; ++m) { const size_t o = (size_t)(row0 + ai * HALF + m * 16) * ldc + col0; float ss = 0.f;
#pragma unroll
                for (int bj = 0; bj < 2; ++bj)
#pragma unroll
                    for (int n = 0; n < 2; ++n) { const f32x4 y = acc[ai][bj][m][n] + *(const f32x4*)(X + o + bj * HALF + n * 16); ss += (y.x * y.x + y.y * y.y) + (y.z * y.z + y.w * y.w); yv[ai][bj][m][n] = y; }
                ss += __shfl_xor(ss, 16); ss += __shfl_xor(ss, 32);
                if (fq == 0) red[((wr * 4 + wc) * 8 + ai * 4 + m) * 16 + fr] = ss; }
        __syncthreads();
        if (tid < 256) { const int w_ = (tid >> 6) & 1, ai = tid >> 7, m = (tid >> 4) & 3, f = tid & 15; float s = 0.f;
#pragma unroll
            for (int c = 0; c < 4; ++c) s += red[((w_ * 4 + c) * 8 + ai * 4 + m) * 16 + f];
            __hip_atomic_store(part + (size_t)(u.pm * BM + tid) * 4 + u.pn, s, __ATOMIC_RELAXED, __HIP_MEMORY_SCOPE_AGENT); }
        asm volatile("s_waitcnt vmcnt(0)" ::: "memory");
        __syncthreads();
        if (tid == 0) { __hip_atomic_fetch_add(cnt + 16 * u.pm, 1u, __ATOMIC_RELAXED, __HIP_MEMORY_SCOPE_AGENT);
            while (__hip_atomic_load(cnt + 16 * u.pm, __ATOMIC_RELAXED, __HIP_MEMORY_SCOPE_AGENT) < 4u) __builtin_amdgcn_s_sleep(2); }
        __syncthreads();
        if (tid < 256) { const float* pp = part + (size_t)(u.pm * BM + tid) * 4; float s = 0.f;
#pragma unroll
            for (int c = 0; c < 4; ++c) s += __hip_atomic_load(pp + c, __ATOMIC_RELAXED, __HIP_MEMORY_SCOPE_AGENT);
            rs[tid] = 1.f / sqrtf(s * (1.f / 1024.f) + eps); }
        __syncthreads();
        f32x4 fw[2][2];
#pragma unroll
        for (int bj = 0; bj < 2; ++bj)
#pragma unroll
            for (int n = 0; n < 2; ++n) fw[bj][n] = *(const f32x4*)(FW + col0 + bj * HALF + n * 16);
#pragma unroll
        for (int ai = 0; ai < 2; ++ai)
#pragma unroll
            for (int m = 0; m < 4; ++m) { const size_t o = (size_t)(row0 + ai * HALF + m * 16) * ldc + col0; const float rstd = rs[ai * HALF + wr * 64 + m * 16 + fr];
#pragma unroll
                for (int bj = 0; bj < 2; ++bj)
#pragma unroll
                    for (int n = 0; n < 2; ++n) *(f32x4*)(Y + o + bj * HALF + n * 16) = yv[ai][bj][m][n] * rstd * fw[bj][n]; }
    }
};
struct EpiRes {
    static constexpr bool PERM = false, AFTER_DRAIN = false;
    const float* X; float* Y; int ldc;
    __device__ __forceinline__ void operator()(const f32x4 (&acc)[2][2][4][2], const Unit& u, int wr, int wc, int fr, int fq) const {
        const int row0 = u.pm * BM + wr * 64 + fr, col0 = u.pn * BM + wc * 32 + 4 * fq;
#pragma unroll
        for (int ai = 0; ai < 2; ++ai)
#pragma unroll
            for (int m = 0; m < 4; ++m) { const size_t o = (size_t)(row0 + ai * HALF + m * 16) * ldc + col0;
#pragma unroll
                for (int bj = 0; bj < 2; ++bj)
#pragma unroll
                    for (int n = 0; n < 2; ++n) *(f32x4*)(Y + o + bj * HALF + n * 16) = acc[ai][bj][m][n] + *(const f32x4*)(X + o + bj * HALF + n * 16); }
    }
};

template <class Epi, class Sched, bool ALIGN_EPI = false, bool SP2 = false>
__device__ __forceinline__ void gemm_phase(PG8_LAS unsigned char* lds, const Gemm g, const Sched& S, const Epi& E) {
    const int tid = threadIdx.x, wid = __builtin_amdgcn_readfirstlane(tid >> 6), lane = tid & 63, wr = wid >> 2, wc = wid & 3, fr = lane & 15, fq = lane >> 4;
    const int K = g.K, nt = K / BK, lda = g.lda, ksplit = g.ksplit; const long a2off = g.a2off;
    unsigned voffA[2], voffB[2];
#pragma unroll
    for (int i = 0; i < 2; ++i) { int R, C; stage_rc(tid * 16 + i * 8192, R, C); const int Rb = Epi::PERM ? ((R & ~31) + perm32(R & 31)) : R;
        voffA[i] = (unsigned)(R * lda + C) * 2u; voffB[i] = (unsigned)(Rb * K + C) * 2u; }
    const size_t kstep = (size_t)(BK * 2);
    const size_t hstep = (size_t)HALF * K * 2;
    const size_t tstep = 2 * hstep; const size_t hstepA = (size_t)HALF * lda * 2, tstepA = 2 * hstepA;
#define PG8_AK(base, t) ((base) + (((t) < ksplit) ? (long)(t) * (long)kstep : a2off + (long)((t) - ksplit) * (long)kstep))
    const unsigned ldsw = (unsigned)wid * 1024u;
    const int aoff = lds_byte(wr * 64 + fr, fq * 8), boff = lds_byte(wc * 32 + fr, fq * 8);
#define PG8_SA(b, h) (((b) * 2 + (h)) * HTB)
#define PG8_SB(b, h) ((4 + (b) * 2 + (h)) * HTB)
#define PG8_STAGE(bufoff, gbase, voff) do { _Pragma("unroll") for (int _i = 0; _i < 2; ++_i) \
        __builtin_amdgcn_global_load_lds((const unsigned*)((const char*)(gbase) + (voff)[_i]), (PG8_LAS unsigned*)(lds + (bufoff) + ldsw + _i * 8192), 16, 0, 0); } while (0)
#define PG8_LDA(dst, b, h) do { _Pragma("unroll") for (int m = 0; m < 4; ++m) _Pragma("unroll") for (int k = 0; k < 2; ++k) dst[m][k] = *(const PG8_LAS bf16x8*)(lds + PG8_SA(b, h) + aoff + m * 2048 + k * 1024); } while (0)
#define PG8_LDB(dst, b, h) do { _Pragma("unroll") for (int n = 0; n < 2; ++n) _Pragma("unroll") for (int k = 0; k < 2; ++k) dst[n][k] = *(const PG8_LAS bf16x8*)(lds + PG8_SB(b, h) + boff + n * 2048 + k * 1024); } while (0)
#define PG8_MMA(ai, bj, At, Bt) do { __builtin_amdgcn_s_setprio(1); _Pragma("unroll") for (int m = 0; m < 4; ++m) _Pragma("unroll") for (int n = 0; n < 2; ++n) _Pragma("unroll") for (int k = 0; k < 2; ++k) \
        acc[ai][bj][m][n] = __builtin_amdgcn_mfma_f32_16x16x32_bf16(Bt[n][k], At[m][k], acc[ai][bj][m][n], 0, 0, 0); __builtin_amdgcn_s_setprio(0); } while (0)
#define PG8_WAIT_V(n) asm volatile("s_waitcnt vmcnt(" #n ")" ::: "memory")
#define PG8_WAIT_L(n) asm volatile("s_waitcnt lgkmcnt(" #n ")" ::: "memory")
#define PG8_BAR __builtin_amdgcn_s_barrier()
#define PG8_SCHED __builtin_amdgcn_sched_barrier(0)
    Unit cur, nxt; int ui = 0;
    if (!S.next(0, cur)) return;
    f32x4 acc[2][2][4][2];
#pragma unroll
    for (int a = 0; a < 2; ++a)
#pragma unroll
        for (int b = 0; b < 2; ++b)
#pragma unroll
            for (int m = 0; m < 4; ++m)
#pragma unroll
                for (int n = 0; n < 2; ++n) acc[a][b][m][n] = (f32x4){0.f, 0.f, 0.f, 0.f};
    bf16x8 At[4][2], B0[2][2], B1[2][2];
    const char* cA = (const char*)g.A + (size_t)cur.pm * tstepA; const char* cB = (const char*)g.Bt + (size_t)cur.pn * tstep;
    S.a_ready(cur);
    if constexpr (SP2) {
        PG8_STAGE(PG8_SB(0, 0), cB, voffB); PG8_STAGE(PG8_SB(0, 1), cB + hstep, voffB); PG8_STAGE(PG8_SA(0, 0), cA, voffA); PG8_STAGE(PG8_SA(0, 1), cA + hstepA, voffA);
        if (wr == 1) PG8_BAR;
        PG8_WAIT_V(2); PG8_BAR;
        PG8_STAGE(PG8_SB(1, 0), cB + kstep, voffB); PG8_STAGE(PG8_SA(1, 0), cA + kstep, voffA); PG8_STAGE(PG8_SB(1, 1), cB + hstep + kstep, voffB);
        PG8_WAIT_V(6); PG8_BAR;
    } else {
        PG8_STAGE(PG8_SB(0, 0), cB, voffB); PG8_STAGE(PG8_SA(0, 0), cA, voffA); PG8_STAGE(PG8_SB(0, 1), cB + hstep, voffB); PG8_STAGE(PG8_SA(0, 1), cA + hstepA, voffA);
        if (wr == 1) PG8_BAR;
        PG8_WAIT_V(4); PG8_BAR;
        PG8_STAGE(PG8_SB(1, 0), cB + kstep, voffB); PG8_STAGE(PG8_SA(1, 0), cA + kstep, voffA); PG8_STAGE(PG8_SB(1, 1), cB + hstep + kstep, voffB);
        PG8_WAIT_V(6); PG8_BAR;
    }
    for (;;) {
        const bool has_next = S.next(ui + 1, nxt);
        const char* nA = has_next ? (const char*)g.A + (size_t)nxt.pm * tstepA : cA; const char* nB = has_next ? (const char*)g.Bt + (size_t)nxt.pn * tstep : cB;
        for (int t = 0; t < nt; t += 2) {
            const bool last = (t == nt - 2);
            const char* a1 = PG8_AK(cA, t + 1);
            const char* a2 = last ? nA : PG8_AK(cA, t + 2); const char* b2 = last ? nB : cB + (size_t)(t + 2) * kstep;
            const char* a3 = last ? nA + kstep : PG8_AK(cA, t + 3); const char* b3 = b2 + kstep;
            if (last && has_next) S.a_ready(nxt);
            if constexpr (SP2) {
            PG8_LDB(B0, 0, 0); PG8_LDB(B1, 0, 1); PG8_SCHED; PG8_LDA(At, 0, 0); PG8_STAGE(PG8_SA(1, 1), a1 + hstepA, voffA);
            PG8_WAIT_V(8); PG8_WAIT_L(0); PG8_BAR; PG8_MMA(0, 0, At, B0); PG8_MMA(0, 1, At, B1); PG8_BAR; PG8_SCHED;
            PG8_LDA(At, 0, 1); PG8_STAGE(PG8_SB(0, 0), b2, voffB); PG8_STAGE(PG8_SB(0, 1), b2 + hstep, voffB); PG8_STAGE(PG8_SA(0, 0), a2, voffA);
            PG8_WAIT_V(8); PG8_WAIT_L(0); PG8_BAR; PG8_MMA(1, 0, At, B0); PG8_MMA(1, 1, At, B1); PG8_BAR; PG8_SCHED;
            PG8_LDB(B0, 1, 0); PG8_LDB(B1, 1, 1); PG8_SCHED; PG8_LDA(At, 1, 0); PG8_STAGE(PG8_SA(0, 1), a2 + hstepA, voffA);
            PG8_WAIT_V(8); PG8_WAIT_L(0); PG8_BAR; PG8_MMA(0, 0, At, B0); PG8_MMA(0, 1, At, B1); PG8_BAR; PG8_SCHED;
            PG8_LDA(At, 1, 1); PG8_STAGE(PG8_SB(1, 0), b3, voffB); PG8_STAGE(PG8_SB(1, 1), b3 + hstep, voffB); PG8_STAGE(PG8_SA(1, 0), a3, voffA);
            PG8_WAIT_V(8); PG8_WAIT_L(0); PG8_BAR; PG8_MMA(1, 0, At, B0); PG8_MMA(1, 1, At, B1); PG8_BAR; PG8_SCHED;
            } else {
            PG8_LDB(B0, 0, 0); PG8_SCHED; PG8_LDA(At, 0, 0); PG8_STAGE(PG8_SA(1, 1), a1 + hstepA, voffA);
            PG8_WAIT_L(8); PG8_BAR; PG8_WAIT_L(0); PG8_MMA(0, 0, At, B0); PG8_BAR; PG8_SCHED;
            PG8_LDB(B1, 0, 1); PG8_STAGE(PG8_SB(0, 0), b2, voffB);
            PG8_BAR; PG8_WAIT_L(0); PG8_MMA(0, 1, At, B1); PG8_BAR;
            PG8_LDA(At, 0, 1); PG8_STAGE(PG8_SA(0, 0), a2, voffA);
            PG8_BAR; PG8_WAIT_L(0); PG8_MMA(1, 0, At, B0); PG8_BAR; PG8_SCHED;
            PG8_STAGE(PG8_SB(0, 1), b2 + hstep, voffB);
            PG8_WAIT_V(6); PG8_BAR; PG8_MMA(1, 1, At, B1); PG8_BAR;
            PG8_LDB(B0, 1, 0); PG8_SCHED; PG8_LDA(At, 1, 0); PG8_STAGE(PG8_SA(0, 1), a2 + hstepA, voffA);
            PG8_WAIT_L(8); PG8_BAR; PG8_WAIT_L(0); PG8_MMA(0, 0, At, B0); PG8_BAR; PG8_SCHED;
            PG8_LDB(B1, 1, 1); PG8_STAGE(PG8_SB(1, 0), b3, voffB);
            PG8_BAR; PG8_WAIT_L(0); PG8_MMA(0, 1, At, B1); PG8_BAR;
            PG8_LDA(At, 1, 1); PG8_STAGE(PG8_SA(1, 0), a3, voffA);
            PG8_BAR; PG8_WAIT_L(0); PG8_MMA(1, 0, At, B0); PG8_BAR; PG8_SCHED;
            PG8_STAGE(PG8_SB(1, 1), b3 + hstep, voffB);
            PG8_WAIT_V(6); PG8_BAR; PG8_MMA(1, 1, At, B1); PG8_BAR;
            }
        }
        if constexpr (ALIGN_EPI) { if (wr == 0) PG8_BAR; }
        if constexpr (!Epi::AFTER_DRAIN) { E(acc, cur, wr, wc, fr, fq); S.done(cur); }
        if (!has_next) break;
#pragma unroll
        for (int a = 0; a < 2; ++a)
#pragma unroll
            for (int b = 0; b < 2; ++b)
#pragma unroll
                for (int m = 0; m < 4; ++m)
#pragma unroll
                    for (int n = 0; n < 2; ++n) acc[a][b][m][n] = (f32x4){0.f, 0.f, 0.f, 0.f};
        cur = nxt; cA = nA; cB = nB; ++ui;
        if constexpr (ALIGN_EPI) { if (wr == 1) PG8_BAR; }
    }
    PG8_WAIT_V(0);
    if constexpr (!ALIGN_EPI) { if (wr == 0) PG8_BAR; }
    PG8_BAR;
    if constexpr (Epi::AFTER_DRAIN) { E.fused(acc, cur, wr, wc, fr, fq, lds, wid, lane); S.done(cur); }
#undef PG8_AK
#undef PG8_SA
#undef PG8_SB
#undef PG8_STAGE
#undef PG8_LDA
#undef PG8_LDB
#undef PG8_MMA
#undef PG8_WAIT_V
#undef PG8_WAIT_L
#undef PG8_BAR
#undef PG8_SCHED
}
}


constexpr int BATCH = 8, T = 2048, D = 1024, M = BATCH * T, NH = 8, HD = 128, PW = 8208, N1 = 8192, KMIX = 2048, CH = 64, NCH = T / CH;
constexpr int NITEM = BATCH * NCH * NH;
constexpr float EPS = 1e-6f;
constexpr int NWAVES = 8;
constexpr size_t MiB = 1u << 20;
constexpr size_t WS_WIN = 1 * MiB;
constexpr size_t WS_WOUT = 17 * MiB;
constexpr size_t WS_G = 21 * MiB;
constexpr size_t WS_BETA = WS_G + 512 * 1024;
constexpr size_t WS_HALO = 22 * MiB;
constexpr size_t WS_EGL = 27 * MiB;
constexpr size_t WS_SSQ = 28 * MiB;
constexpr size_t WS_HB = 32 * MiB;
constexpr size_t WS_ACT = 64 * MiB;
constexpr size_t ACTSZ = (size_t)M * 1024;
constexpr size_t WS_END = 256 * MiB;
static_assert(WS_ACT + 6 * ACTSZ * 2 == WS_END, "ws map");
constexpr int LDS_BYTES = 147456;

#define LAS __attribute__((address_space(3)))
#define DI __device__ __forceinline__
typedef unsigned short bf16;
typedef unsigned v4u __attribute__((ext_vector_type(4)));
typedef unsigned v2u __attribute__((ext_vector_type(2)));
typedef float f32x4 __attribute__((ext_vector_type(4)));
typedef float f32x2 __attribute__((ext_vector_type(2)));
typedef short bf16x8 __attribute__((ext_vector_type(8)));
using pg8::cvt_pk_bf16;
using pg8::cvt_pk_bf16_v;
using pg8::silu_f;
DI float bf_lo(unsigned u) { return __uint_as_float(u << 16); }
DI float bf_hi(unsigned u) { return __uint_as_float(u & 0xffff0000u); }
#define DPP_MOV(x, ctrl) __int_as_float(__builtin_amdgcn_mov_dpp(__float_as_int(x), (ctrl), 0xF, 0xF, true))
#define DPP_UPD0(x, ctrl, rmask) __int_as_float(__builtin_amdgcn_update_dpp(0, __float_as_int(x), (ctrl), (rmask), 0xF, false))
DI float row16_sum(float v) { v += DPP_MOV(v, 0xB1); v += DPP_MOV(v, 0x4E); v += DPP_MOV(v, 0x141); v += DPP_MOV(v, 0x140); return v; }
DI float wave_sum(float v) {
    v = row16_sum(v);
    v += DPP_UPD0(v, 0x142, 0xA);
    v += DPP_UPD0(v, 0x143, 0xC);
    return __int_as_float(__builtin_amdgcn_readlane(__float_as_int(v), 63));
}
DI int posf(int idx) { return (idx & ~31) | (((idx >> 2) & 3) << 3) | (((idx >> 4) & 1) << 2) | (idx & 3); }
constexpr int permf(int p) { return (p & ~31) | (((p >> 2) & 1) << 4) | (((p >> 3) & 3) << 2) | (p & 3); }
#define LDSV(T, name, src) unsigned name##_u = (unsigned)(size_t)(src); asm volatile("" : "+v"(name##_u)); T name = (T)name##_u
#ifndef DBG_NO_HALO
#define DBG_NO_HALO 0
#endif
#define MFMA16(a, b, c) __builtin_amdgcn_mfma_f32_16x16x32_bf16((a), (b), (c), 0, 0, 0)

struct Args { const float* in[11]; float* out; unsigned char* ws; };

#define XB_TMO      128
#define XB_XCNT(j)  (256  + 64 * (j))
#define XB_XSUB(j)  (1280 + 64 * (j))
#define XB_XGEN(j)  (2304 + 64 * (j))
#define XB_TOP      3328
#define XB_TOPGEN   3392
#define XCD_BAR_WORDS 3456
#define XB_SPIN_CAP (1u << 18)

__device__ __forceinline__ unsigned xb_ld(unsigned* p)              { return __hip_atomic_load(p, __ATOMIC_RELAXED, __HIP_MEMORY_SCOPE_AGENT); }
__device__ __forceinline__ unsigned xb_add(unsigned* p, unsigned v) { return __hip_atomic_fetch_add(p, v, __ATOMIC_RELAXED, __HIP_MEMORY_SCOPE_AGENT); }
__device__ __forceinline__ unsigned xb_xcc_id() { return (unsigned)__builtin_amdgcn_s_getreg((3 << 11) | 20) & 0xFu; }
#define XB_SPIN(cond, bar) do { unsigned _sp = 0; while (cond) { __builtin_amdgcn_s_sleep(1); \
    if ((++_sp & 255u) == 0u) { if (xb_ld(&(bar)[XB_TMO])) break; if (_sp > XB_SPIN_CAP) { atomicAdd(&(bar)[XB_TMO], 1u); break; } } } } while (0)

struct XcdBarrier {
    unsigned* bar; unsigned x;
    volatile LAS unsigned* st;
};

__device__ __forceinline__ XcdBarrier xcd_barrier_post(unsigned* bar, volatile LAS unsigned* st) {
    XcdBarrier b; b.bar = bar; b.x = xb_xcc_id(); b.st = st;
    if (threadIdx.x == 0) (void)xb_add(&bar[XB_XCNT(b.x)], 1u);
    return b;
}
__device__ __forceinline__ void xcd_barrier_complete(unsigned* bar, unsigned x, unsigned& nloc, unsigned& nx) {
    const unsigned G = gridDim.x * gridDim.y * gridDim.z;
    unsigned sum, cnt, mine, sp = 0u;
    for (;;) {
        sum = 0u; cnt = 0u; mine = 0u;
#pragma unroll
        for (unsigned j = 0; j < 16; ++j) { const unsigned c = xb_ld(&bar[XB_XCNT(j)]); sum += c; cnt += (c > 0u) ? 1u : 0u; mine = (j == x) ? c : mine; }
        if (sum == G) break;
        __builtin_amdgcn_s_sleep(1);
        if ((++sp & 255u) == 0u) { if (xb_ld(&bar[XB_TMO])) break; if (sp > XB_SPIN_CAP) { atomicAdd(&bar[XB_TMO], 1u); break; } }
    }
    nloc = mine > 0u ? mine : 1u; nx = cnt > 0u ? cnt : 1u;
}

__device__ __forceinline__ void xcd_barrier(const XcdBarrier& b) {
    asm volatile("s_waitcnt vmcnt(0)" ::: "memory");
    __syncthreads();
    if (threadIdx.x == 0) {
        unsigned* bar = b.bar;
        __builtin_amdgcn_s_waitcnt(0);
        unsigned nloc = b.st[0], nx = b.st[1];
        if (nloc == 0u) { xcd_barrier_complete(bar, b.x, nloc, nx); b.st[0] = nloc; b.st[1] = nx; }
        const unsigned old = xb_add(&bar[XB_XSUB(b.x)], 1u);
        const unsigned gen = old / nloc;
        if (old + 1u == (gen + 1u) * nloc) {
            __builtin_amdgcn_fence(__ATOMIC_RELEASE, "agent");
            asm volatile("s_waitcnt vmcnt(0)" ::: "memory");
            const unsigned og = xb_add(&bar[XB_TOP], 1u);
            const unsigned tg = og / nx;
            if (og + 1u == (tg + 1u) * nx) xb_add(&bar[XB_TOPGEN], 1u);
            else XB_SPIN(xb_ld(&bar[XB_TOPGEN]) == tg, bar);
            __builtin_amdgcn_fence(__ATOMIC_ACQUIRE, "agent");
            xb_add(&bar[XB_XGEN(b.x)], 1u);
            asm volatile("s_waitcnt vmcnt(0)" ::: "memory");
        } else {
            XB_SPIN(xb_ld(&bar[XB_XGEN(b.x)]) == gen, bar);
            __builtin_amdgcn_fence(__ATOMIC_ACQUIRE, "agent");
            asm volatile("s_waitcnt vmcnt(0)" ::: "memory");
        }
    }
    __syncthreads();
}


DI int srccol(int n0) {
    if (n0 < 4096) return n0;
    if (n0 < 6144) { const int r = n0 - 4096, tau = r >> 8, w = r & 255; return w < 128 ? 5136 + 128 * tau + w : 6160 + 128 * tau + (w - 128); }
    const int r = n0 - 6144, tau = r >> 8, w = r & 255; return w < 128 ? 4112 + 128 * tau + w : 7184 + 128 * tau + (w - 128);
}
DI void transpose_item(const float* W, int ldw, int srccol0, bf16* WT, int K, int n0, int k0, LAS float* scr, int lane) {
    f32x4 ld[8];
#pragma unroll
    for (int i = 0; i < 8; ++i) { const int pc = lane + 64 * i, kk = pc >> 3, n4 = pc & 7; ld[i] = *(const f32x4*)(W + (size_t)(k0 + kk) * ldw + srccol0 + 4 * n4); }
#pragma unroll
    for (int i = 0; i < 8; ++i) { const int pc = lane + 64 * i, kk = pc >> 3, n4 = pc & 7; LAS float* d = scr + kk * 33 + 4 * n4; d[0] = ld[i].x; d[1] = ld[i].y; d[2] = ld[i].z; d[3] = ld[i].w; }
    asm volatile("s_waitcnt lgkmcnt(0)" ::: "memory");
    const int c = lane & 7;
#pragma unroll
    for (int j = 0; j < 4; ++j) { const int n = (lane >> 3) + 8 * j; const LAS float* s = scr + (8 * c) * 33 + n;
        v4u o; o.x = cvt_pk_bf16(s[0 * 33], s[1 * 33]); o.y = cvt_pk_bf16(s[2 * 33], s[3 * 33]); o.z = cvt_pk_bf16(s[4 * 33], s[5 * 33]); o.w = cvt_pk_bf16(s[6 * 33], s[7 * 33]);
        *(v4u*)(WT + (size_t)(n0 + n) * K + k0 + 8 * c) = o; }
    asm volatile("s_waitcnt lgkmcnt(0)" ::: "memory");
}
DI void p0_prologue(const Args& a, LAS unsigned char* lds, int vcu, int G, int tid, int lane, int wave) {
    unsigned char* ws = a.ws;
    const float* x = a.in[0]; const float* norm_w = a.in[1]; const float* w_in = a.in[2]; const float* A_log = a.in[4]; const float* dt_bias = a.in[5]; const float* w_out = a.in[9];
    bf16* WinT = (bf16*)(ws + WS_WIN); bf16* WoutT = (bf16*)(ws + WS_WOUT); bf16* HB = (bf16*)(ws + WS_HB);
    float* Gb = (float*)(ws + WS_G); float* Bb = (float*)(ws + WS_BETA);
    LAS float* scr = (LAS float*)(lds + wave * 16384);
    const int gw = vcu * NWAVES + wave, NGW = G * NWAVES;
    constexpr int I_IN = (D / 64) * (N1 / 32), I_OUT = (KMIX / 64) * (D / 32);
#define P0_LOAD(dst, mb) do { _Pragma("unroll") for (int u = 0; u < 4; ++u) { const f32x4* xr_ = (const f32x4*)(x + (size_t)min((mb) + u * NGW, M - 1) * D) + lane; \
        _Pragma("unroll") for (int j = 0; j < 4; ++j) dst[u][j] = xr_[64 * j]; } } while (0)
    f32x4 vv[4][4], vnx[4][4];
    P0_LOAD(vv, gw);
    for (int it = gw; it < I_IN + I_OUT; it += NGW) {
        if (it < I_IN) { const int kb = it / (N1 / 32), nb = it % (N1 / 32); transpose_item(w_in, PW, srccol(32 * nb), WinT, D, 32 * nb, 64 * kb, scr, lane); }
        else { const int r = it - I_IN, kb = r / (D / 32), nb = r % (D / 32); transpose_item(w_out, D, 32 * nb, WoutT, KMIX, 32 * nb, 64 * kb, scr, lane); }
    }
    __syncthreads();
    LAS float* wbg = (LAS float*)lds;
    {   float tmpw[32];
#pragma unroll
        for (int i = 0; i < 32; ++i) { const int idx = tid + 512 * i, k = idx >> 4, c = idx & 15; tmpw[i] = w_in[(size_t)k * PW + 4096 + c]; }
#pragma unroll
        for (int i = 0; i < 32; ++i) { const int idx = tid + 512 * i, k = idx >> 4, c = idx & 15; wbg[c * 1024 + k] = tmpw[i]; } }
    __syncthreads();
    const LAS f32x4* wb4 = (const LAS f32x4*)wbg;
    f32x4 nw[4];
#pragma unroll
    for (int j = 0; j < 4; ++j) nw[j] = ((const f32x4*)norm_w)[lane + 64 * j];
    for (int m0 = gw; m0 < M; m0 += 4 * NGW) {
        int mr[4];
#pragma unroll
        for (int u = 0; u < 4; ++u) mr[u] = min(m0 + u * NGW, M - 1);
        if (m0 + 4 * NGW < M) P0_LOAD(vnx, m0 + 4 * NGW);
#pragma unroll
        for (int u = 0; u < 4; ++u) { float s = 0.f;
#pragma unroll
            for (int j = 0; j < 4; ++j) s += (vv[u][j].x * vv[u][j].x + vv[u][j].y * vv[u][j].y) + (vv[u][j].z * vv[u][j].z + vv[u][j].w * vv[u][j].w);
            const float rstd = __builtin_amdgcn_rsqf(wave_sum(s) * (1.f / D) + EPS);
            unsigned long long* o8 = (unsigned long long*)(HB + (size_t)mr[u] * D) + lane;
#pragma unroll
            for (int j = 0; j < 4; ++j) { vv[u][j] = vv[u][j] * rstd * nw[j];
                o8[64 * j] = (unsigned long long)cvt_pk_bf16(vv[u][j].x, vv[u][j].y) | ((unsigned long long)cvt_pk_bf16(vv[u][j].z, vv[u][j].w) << 32); } }
        float ds[64];
#pragma unroll
        for (int c = 0; c < 16; ++c) { f32x2 d2[4] = {{0.f, 0.f}, {0.f, 0.f}, {0.f, 0.f}, {0.f, 0.f}};
#pragma unroll
            for (int j = 0; j < 4; ++j) { const f32x4 w = wb4[c * 256 + lane + 64 * j]; const f32x2 w01 = {w.x, w.y}, w23 = {w.z, w.w};
#pragma unroll
                for (int u = 0; u < 4; ++u) { d2[u] = d2[u] + (f32x2){vv[u][j].x, vv[u][j].y} * w01; d2[u] = d2[u] + (f32x2){vv[u][j].z, vv[u][j].w} * w23; } }
#pragma unroll
            for (int u = 0; u < 4; ++u) ds[16 * u + c] = d2[u].x + d2[u].y; }
#pragma unroll
        for (int o = 32; o >= 1; o >>= 1) { const bool up = (lane & o) != 0;
#pragma unroll
            for (int k = 0; k < o; ++k) { const float lo = ds[k], hi = ds[k + o]; const float send = up ? lo : hi, keep = up ? hi : lo; ds[k] = keep + __shfl_xor(send, o); } }
        {   const float sel = ds[0]; const int u = lane >> 4, c = lane & 15; const int m = (u == 0) ? mr[0] : (u == 1 ? mr[1] : (u == 2 ? mr[2] : mr[3]));
            if (c < 8) Bb[(size_t)m * 8 + c] = 1.f / (1.f + expf(-sel));
            else { const int h = c - 8; const float xx = sel + dt_bias[h]; const float sp = fmaxf(xx, 0.f) + log1pf(expf(-fabsf(xx))); Gb[(size_t)m * 8 + h] = -expf(A_log[h]) * sp; } }
#pragma unroll
        for (int u = 0; u < 4; ++u)
#pragma unroll
            for (int j = 0; j < 4; ++j) vv[u][j] = vnx[u][j];
    }
#undef P0_LOAD
}

constexpr int KN_STRIDE = 136;
constexpr int AT_STRIDE = 68;
constexpr int PA_KN = 0, PA_QN = 64 * KN_STRIDE * 2, PA_AT = 2 * PA_QN, PA_VH = PA_AT + 64 * AT_STRIDE * 4, PA_SM = PA_VH + 64 * KN_STRIDE * 2, PA_ITEM_LDS = PA_SM + 1024;
static_assert(2 * PA_ITEM_LDS <= LDS_BYTES, "PA LDS");

DI void tri_solve(f32x2 (&X)[64], const LAS float* A) {
#ifdef DBG_NO_SOLVE
    return;
#endif
    const unsigned a_u = (unsigned)(size_t)A;
#pragma unroll
    for (int i = 1; i < 64; ++i) {
        unsigned ai = a_u + i * AT_STRIDE * 4;
        asm volatile("" : "+v"(ai) : "v"(X[(i < 32) ? (i >= 2 ? i - 2 : 0) : i - 1].x));
        const LAS float* rowp = (const LAS float*)ai;
        f32x2 acc[4] = {X[i], {0.f, 0.f}, {0.f, 0.f}, {0.f, 0.f}};
#pragma unroll
        for (int j4 = 0; 4 * j4 < i; ++j4) {
            const f32x4 av = *(const LAS f32x4*)(rowp + 4 * j4);
            acc[0] = acc[0] - X[4 * j4] * av.x;
            if (4 * j4 + 1 < i) acc[1] = acc[1] - X[4 * j4 + 1] * av.y;
            if (4 * j4 + 2 < i) acc[2] = acc[2] - X[4 * j4 + 2] * av.z;
            if (4 * j4 + 3 < i) acc[3] = acc[3] - X[4 * j4 + 3] * av.w;
        }
        X[i] = (acc[0] + acc[1]) + (acc[2] + acc[3]);
    }
}

DI void pa_phase(const Args& a, LAS unsigned char* lds, int G, int tid, int lane, int wave) {
    unsigned char* ws = a.ws;
    const float* conv_qkv_w = a.in[3];
    bf16* ACT = (bf16*)(ws + WS_ACT); const bf16* HALO = (const bf16*)(ws + WS_HALO); bf16* Wb = (bf16*)(ws + WS_HB);
    const float* Gb = (const float*)(ws + WS_G); const float* Bb = (const float*)(ws + WS_BETA); float* EGL = (float*)(ws + WS_EGL);
    bf16* ATTN = (bf16*)a.out;
    const int sg = wave >> 2, role = (wave & 3) ^ (sg << 1), tsg = tid & 255;
    LAS unsigned char* base = lds + sg * PA_ITEM_LDS;
    LAS unsigned char* KnB = base + PA_KN; LAS unsigned char* QnB = base + PA_QN; LAS unsigned char* ATB = base + PA_AT; LAS unsigned char* VhB = base + PA_VH;
    LAS bf16* Kn = (LAS bf16*)KnB; LAS bf16* Qn = (LAS bf16*)QnB; LAS float* AT = (LAS float*)ATB; LAS float* sm = (LAS float*)(base + PA_SM);
#ifdef DBG_NO_ITEMS
    const int nrounds = 0;
#else
    const int nrounds = (NITEM + 2 * G - 1) / (2 * G);
#endif
    for (int round = 0; round < nrounds; ++round) {
        int ln, tsl;
        const int item = (round * G + (int)blockIdx.x) * 2 + sg; const bool valid = item < NITEM;
        const int h = item & 7, c = (item >> 3) & 31, b = item >> 8; const size_t row0 = (size_t)b * T + (size_t)c * CH;
        ln = lane; tsl = tsg; asm volatile("" : "+v"(ln), "+v"(tsl));
        if (valid) {
            const int seg = tsl & 15, rr0 = tsl >> 4;
            const bf16* hb_ = HALO + ((size_t)(b * NCH + c - 1) * 3) * 3072 + h * HD + seg * 8;
            const bf16* gb_ = ACT + row0 * 1024 + h * HD + seg * 8;
#pragma unroll
            for (int tens = 0; tens < 3; ++tens) {
                LAS unsigned char* dreg = (tens == 0 ? QnB : (tens == 1 ? KnB : ATB)) + seg * 16;
                v4u v[5];
#pragma unroll
                for (int k = 0; k < 5; ++k) { const int rr = rr0 + 16 * k; v[k] = (v4u){0u, 0u, 0u, 0u};
                    if (rr < 67) { if (rr >= 3) v[k] = *(const v4u*)(gb_ + (size_t)tens * ACTSZ + (size_t)(rr - 3) * 1024); else if (c > 0) v[k] = *(const v4u*)(hb_ + (size_t)rr * 3072 + tens * 1024); } }
#pragma unroll
                for (int k = 0; k < 5; ++k) { const int rr = rr0 + 16 * k; if (rr < 67) *(LAS v4u*)(dreg + rr * 256) = v[k]; }
            }
        }
        __syncthreads();
        ln = lane; tsl = tsg; asm volatile("" : "+v"(ln), "+v"(tsl));
        if (valid && role < 3) {
            const int ti = (role == 0) ? 2 : (role == 1 ? 1 : 0);
            const LAS unsigned* rp = (const LAS unsigned*)(role == 0 ? ATB : (role == 1 ? KnB : QnB)) + ln;
            const float* cwp = conv_qkv_w + ti * 1024 + h * HD + 2 * ln;
            f32x2 cw[4];
#pragma unroll
            for (int j = 0; j < 4; ++j) { cw[j].x = cwp[j * 3072]; cw[j].y = cwp[j * 3072 + 1]; }
            f32x2 val[64];
            unsigned x0 = rp[0], x1 = rp[64], x2 = rp[128];
#pragma unroll
            for (int i = 0; i < 64; ++i) { const unsigned x3 = rp[(i + 3) * 64];
                f32x2 s;
                s.x = cw[0].x * bf_lo(x0) + cw[1].x * bf_lo(x1) + cw[2].x * bf_lo(x2) + cw[3].x * bf_lo(x3);
                s.y = cw[0].y * bf_hi(x0) + cw[1].y * bf_hi(x1) + cw[2].y * bf_hi(x2) + cw[3].y * bf_hi(x3);
#ifdef DBG_COPY_V
                val[i].x = bf_lo(x3); val[i].y = bf_hi(x3);
#else
                val[i].x = silu_f(s.x); val[i].y = silu_f(s.y);
#endif
                x0 = x1; x1 = x2; x2 = x3; }
            LAS unsigned* dst = (LAS unsigned*)(role == 0 ? VhB : (role == 1 ? KnB : QnB)) + ln;
            if (role != 0) {
                const float sc = (role == 2) ? 0.08838834764831845f : 1.f;
#pragma unroll
                for (int hb = 0; hb < 64; hb += 32) {
                    float ssq[32];
#pragma unroll
                    for (int i = 0; i < 32; ++i) ssq[i] = val[hb + i].x * val[hb + i].x + val[hb + i].y * val[hb + i].y;
#pragma unroll
                    for (int i = 0; i < 32; ++i) ssq[i] += DPP_MOV(ssq[i], 0xB1);
#pragma unroll
                    for (int i = 0; i < 32; ++i) ssq[i] += DPP_MOV(ssq[i], 0x4E);
#pragma unroll
                    for (int i = 0; i < 32; ++i) ssq[i] += DPP_MOV(ssq[i], 0x141);
#pragma unroll
                    for (int i = 0; i < 32; ++i) ssq[i] += DPP_MOV(ssq[i], 0x140);
#pragma unroll
                    for (int i = 0; i < 32; ++i) ssq[i] += DPP_UPD0(ssq[i], 0x142, 0xA);
#pragma unroll
                    for (int i = 0; i < 32; ++i) ssq[i] += DPP_UPD0(ssq[i], 0x143, 0xC);
#pragma unroll
                    for (int i = 0; i < 32; ++i) { const float tot = __int_as_float(__builtin_amdgcn_readlane(__float_as_int(ssq[i]), 63)); const float rs = sc * __builtin_amdgcn_rsqf(tot + EPS);
                        dst[(hb + i) * (KN_STRIDE / 2)] = cvt_pk_bf16(val[hb + i].x * rs, val[hb + i].y * rs); }
                    __builtin_amdgcn_sched_barrier(0);
                }
            } else {
#pragma unroll
                for (int i = 0; i < 64; ++i) dst[i * (KN_STRIDE / 2)] = cvt_pk_bf16(val[i].x, val[i].y);
            }
        } else if (valid) {
#ifdef DBG_CONST_GATES
            float v = -0.05f; const float bi = 0.5f;
#else
            float v = Gb[(row0 + ln) * 8 + h]; const float bi = Bb[(row0 + ln) * 8 + h];
#endif
#pragma unroll
            for (int o = 1; o < 64; o <<= 1) { const float t = __shfl_up(v, o); if (ln >= o) v += t; }
            const float gl = __shfl(v, 63);
            sm[ln] = v; sm[64 + ln] = bi; sm[128 + ln] = __expf(v); sm[192 + ln] = __expf(gl - v);
            if (ln == 63) EGL[item] = __expf(v);
        }
        __syncthreads();
        ln = lane; tsl = tsg; asm volatile("" : "+v"(ln), "+v"(tsl));
        if (valid) {
            const int r = ln & 15, q = ln >> 4, ti_ = role;
            LDSV(LAS float*, smv, sm); LDSV(LAS float*, ATv, AT); LDSV(LAS bf16*, Knv, Kn); LDSV(LAS bf16*, Qnv, Qn);
            bf16x8 ki[4], qi[4];
#pragma unroll
            for (int s = 0; s < 4; ++s) { ki[s] = *(const LAS bf16x8*)(Knv + (16 * ti_ + r) * KN_STRIDE + 32 * s + 8 * q); qi[s] = *(const LAS bf16x8*)(Qnv + (16 * ti_ + r) * KN_STRIDE + 32 * s + 8 * q); }
            bf16* attn_i = ATTN + (size_t)item * 4096 + (16 * ti_ + r) * 64 + 8 * q;
            const float gci2 = smv[16 * ti_ + r], bi2 = smv[64 + 16 * ti_ + r];
#pragma unroll
            for (int tj = 0; tj < 4; ++tj) {
                bf16* ap = attn_i + 32 * (tj >> 1) + 4 * (tj & 1);
                if (tj <= ti_) {
                    f32x4 c1 = {0.f, 0.f, 0.f, 0.f}, c2 = {0.f, 0.f, 0.f, 0.f};
#pragma unroll
                    for (int s = 0; s < 4; ++s) { const bf16x8 kj = *(const LAS bf16x8*)(Knv + (16 * tj + r) * KN_STRIDE + 32 * s + 8 * q); c1 = MFMA16(kj, ki[s], c1); c2 = MFMA16(kj, qi[s], c2); }
                    const int i2 = 16 * ti_ + r; float p[4];
                    f32x4 o;
#pragma unroll
                    for (int e = 0; e < 4; ++e) { const int j2 = 16 * tj + 4 * q + e; o[e] = (j2 < i2) ? bi2 * __expf(gci2 - smv[j2]) * c1[e] : 0.f; }
                    { v2u na; na.x = cvt_pk_bf16(-o[0], -o[1]); na.y = cvt_pk_bf16(-o[2], -o[3]); *(LAS v2u*)((LAS unsigned char*)ATv + i2 * 144 + (16 * tj + 4 * q) * 2) = na; }
                    if (tj == ti_) *(LAS f32x4*)((LAS unsigned char*)ATv + 9216 + ((ti_ * 16 + r) * 16 + 4 * q) * 4) = o;
#pragma unroll
                    for (int e = 0; e < 4; ++e) { const int j2 = 16 * tj + 4 * q + e; p[e] = (j2 <= i2) ? __expf(gci2 - smv[j2]) * c2[e] : 0.f; }
                    v2u w; w.x = cvt_pk_bf16(p[0], p[1]); w.y = cvt_pk_bf16(p[2], p[3]); *(v2u*)ap = w;
                } else { v2u w; w.x = 0u; w.y = 0u; *(v2u*)ap = w; }
            }
        }
        __syncthreads();
        ln = lane; tsl = tsg; asm volatile("" : "+v"(ln), "+v"(tsl));
        if (valid) {
            LDSV(LAS float*, smv, sm); LDSV(LAS unsigned char*, QnBv, QnB); LDSV(LAS bf16*, Knv, Kn);
            for (int pc = tsl; pc < 1024; pc += 256) {
                const int i = pc >> 4, sg8 = pc & 15, s = sg8 >> 2, q = sg8 & 3; const float e = smv[128 + i];
                const v2u lo = *(const LAS v2u*)(QnBv + i * 272 + (32 * s + 4 * q) * 2), hi = *(const LAS v2u*)(QnBv + i * 272 + (32 * s + 16 + 4 * q) * 2);
                v4u o; o.x = cvt_pk_bf16(bf_lo(lo.x) * e, bf_hi(lo.x) * e); o.y = cvt_pk_bf16(bf_lo(lo.y) * e, bf_hi(lo.y) * e); o.z = cvt_pk_bf16(bf_lo(hi.x) * e, bf_hi(hi.x) * e); o.w = cvt_pk_bf16(bf_lo(hi.y) * e, bf_hi(hi.y) * e);
                *(v4u*)(ACT + (row0 + i) * 1024 + h * HD + sg8 * 8) = o; }
            for (int pc = tsl; pc < 1024; pc += 256) {
                const int dk = pc >> 3, g = pc & 7, s = g >> 2, q = g & 3; float f[8];
#pragma unroll
                for (int e = 0; e < 8; ++e) { const int j = 32 * s + 16 * (e >> 2) + 4 * q + (e & 3); f[e] = __uint_as_float((unsigned)Knv[j * KN_STRIDE + dk] << 16) * smv[192 + j]; }
                v4u o; o.x = cvt_pk_bf16(f[0], f[1]); o.y = cvt_pk_bf16(f[2], f[3]); o.z = cvt_pk_bf16(f[4], f[5]); o.w = cvt_pk_bf16(f[6], f[7]);
                *(v4u*)(ACT + ACTSZ + (row0 + (dk >> 1)) * 1024 + h * HD + (dk & 1) * 64 + g * 8) = o; }
        }
        __syncthreads();
        ln = lane; tsl = tsg; asm volatile("" : "+v"(ln), "+v"(tsl));
        f32x4 Rv[4][4];
        const int cbase = 64 * (role & 1);
        if (valid) {
            LDSV(LAS float*, smv, sm);
            const int r = ln & 15, q = ln >> 4;
            const LAS bf16* tile = (const LAS bf16*)(role < 2 ? VhB : KnB);
#pragma unroll
            for (int bb = 0; bb < 4; ++bb)
#pragma unroll
                for (int e = 0; e < 4; ++e) { const int row = 16 * bb + 4 * q + e; const float be = smv[64 + row], eg = smv[128 + row]; const float f = (role < 2) ? be : be * eg;
#pragma unroll
                    for (int nt = 0; nt < 4; ++nt) Rv[nt][bb][e] = __uint_as_float((unsigned)tile[row * KN_STRIDE + cbase + 16 * nt + r] << 16) * f; }
        }
        __syncthreads();
        ln = lane; tsl = tsg; asm volatile("" : "+v"(ln), "+v"(tsl));
        if (valid) {
            LAS unsigned char* XT = (role < 2 ? VhB : KnB);
            {   LAS unsigned char* zp = XT + cbase * 136 + ln * 16;
                const v4u z4 = {0u, 0u, 0u, 0u};
#pragma unroll
                for (int k = 0; k < 8; ++k) *(LAS v4u*)(zp + 1024 * k) = z4;
                if (ln < 32) *(LAS v4u*)(zp + 8192) = z4; }
            if (role == 0) {
                LDSV(LAS unsigned char*, ATu, ATB);
                const int tb = ln >> 4, tc = ln & 15;
                const LAS float* adg = (const LAS float*)(ATu + 9216) + tb * 256;
                float t[16];
#pragma unroll
                for (int i = 0; i < 16; ++i) { float acc = (tc == i) ? 1.f : 0.f;
#pragma unroll
                    for (int j4 = 0; 4 * j4 < i; ++j4) { const f32x4 av = *(const LAS f32x4*)(adg + i * 16 + 4 * j4);
                        acc -= av.x * t[4 * j4]; if (4 * j4 + 1 < i) acc -= av.y * t[4 * j4 + 1]; if (4 * j4 + 2 < i) acc -= av.z * t[4 * j4 + 2]; if (4 * j4 + 3 < i) acc -= av.w * t[4 * j4 + 3]; }
                    t[i] = acc; }
                LAS unsigned char* tp = ATu + 13312 + tb * 1024 + (8 * (tc >> 2) + (tc & 3)) * 2;
#pragma unroll
                for (int i = 0; i < 16; ++i) { const float to = DPP_MOV(t[i], 0xB1);
                    if ((tc & 1) == 0) *(LAS unsigned*)(tp + i * 64) = cvt_pk_bf16(t[i], to);
                    if ((tc & 3) == 0) { v2u z2; z2.x = 0u; z2.y = 0u; *(LAS v2u*)(tp + i * 64 + 8) = z2; } }
            }
        }
        __syncthreads();
        ln = lane; tsl = tsg; asm volatile("" : "+v"(ln), "+v"(tsl));
        if (valid) {
            LDSV(LAS unsigned char*, ATu, ATB);
            LAS unsigned char* XT = (role < 2 ? VhB : KnB);
            const int r = ln & 15, q = ln >> 4;
            LAS unsigned char* xcol = XT + (cbase + r) * 136;
#pragma unroll
            for (int bb = 0; bb < 4; ++bb) {
                const bf16x8 tf = *(const LAS bf16x8*)(ATu + 13312 + ((bb * 16 + r) * 32 + 8 * q) * 2);
                bf16x8 af[2];
#pragma unroll
                for (int ks = 0; ks < 2; ++ks) if (32 * ks < 16 * bb) af[ks] = *(const LAS bf16x8*)(ATu + (16 * bb + r) * 144 + (32 * ks + 8 * q) * 2);
#pragma unroll
                for (int nt = 0; nt < 4; ++nt) {
                    f32x4 acc = Rv[nt][bb];
#pragma unroll
                    for (int ks = 0; ks < 2; ++ks) if (32 * ks < 16 * bb) {
                        const v2u lo = *(const LAS v2u*)(xcol + nt * (16 * 136) + (32 * ks + 8 * q) * 2), hi = *(const LAS v2u*)(xcol + nt * (16 * 136) + (32 * ks + 8 * q) * 2 + 8);
                        v4u bw; bw.x = lo.x; bw.y = lo.y; bw.z = hi.x; bw.w = hi.y;
                        acc = MFMA16(af[ks], __builtin_bit_cast(bf16x8, bw), acc); }
                    v4u rw; rw.x = cvt_pk_bf16_v(acc[0], acc[1]); rw.y = cvt_pk_bf16_v(acc[2], acc[3]); rw.z = 0u; rw.w = 0u;
                    const f32x4 zero4 = {0.f, 0.f, 0.f, 0.f};
                    const f32x4 x = MFMA16(tf, __builtin_bit_cast(bf16x8, rw), zero4);
                    v2u xw; xw.x = cvt_pk_bf16_v(x[0], x[1]); xw.y = cvt_pk_bf16_v(x[2], x[3]);
                    *(LAS v2u*)(xcol + nt * (16 * 136) + (16 * bb + 4 * q) * 2) = xw;
                }
            }
        }
        __syncthreads();
        ln = lane; tsl = tsg; asm volatile("" : "+v"(ln), "+v"(tsl));
        if (valid) {
            for (int pc = tsl; pc < 2048; pc += 256) { const int which = pc >> 10, id = pc & 1023, i = id & 63, seg = id >> 6;
                const LAS bf16* xt = (const LAS bf16*)(which ? KnB : VhB) + i;
                unsigned short v[8];
#pragma unroll
                for (int e = 0; e < 8; ++e) { const int p = seg * 8 + e; const int col = which ? ((p & ~31) | (((p >> 2) & 1) << 4) | (((p >> 3) & 3) << 2) | (p & 3)) : p; v[e] = xt[col * 68]; }
                v4u o; o.x = (unsigned)v[0] | ((unsigned)v[1] << 16); o.y = (unsigned)v[2] | ((unsigned)v[3] << 16); o.z = (unsigned)v[4] | ((unsigned)v[5] << 16); o.w = (unsigned)v[6] | ((unsigned)v[7] << 16);
                bf16* dstp = which ? (Wb + (row0 + i) * 1024 + h * HD + seg * 8) : (ACT + 2 * ACTSZ + (row0 + i) * 1024 + h * HD + seg * 8);
                *(v4u*)dstp = o; }
        }
        __syncthreads();
    }
}

DI void yc_phase(const Args& a, int first, int G, int tid) {
    unsigned char* ws = a.ws; bf16* ACT = (bf16*)(ws + WS_ACT);
    {
        const float* conv_w = a.in[7]; const float* conv_b = a.in[8];
        const bf16* Pb = ACT + 4 * ACTSZ; bf16* Sb = ACT + 5 * ACTSZ;
        const int cgp = tid & 127, rq = tid >> 7, col = cgp * 8;
        float w0[8], w1[8], w2[8], bb[8];
#pragma unroll
        for (int e = 0; e < 8; ++e) { w0[e] = conv_w[col + e]; w1[e] = conv_w[1024 + col + e]; w2[e] = conv_w[2048 + col + e]; bb[e] = conv_b[col + e]; }
        for (int rc = (int)blockIdx.x - first; rc < M / 64; rc += G - first) {
            const size_t r0 = (size_t)rc * 64 + rq * 16;
            v4u pm2 = {0u, 0u, 0u, 0u}, pm1 = {0u, 0u, 0u, 0u};
            if ((r0 & (T - 1)) != 0) { pm2 = *(const v4u*)(Pb + (r0 - 2) * 1024 + col); pm1 = *(const v4u*)(Pb + (r0 - 1) * 1024 + col); }
#pragma unroll 4
            for (int i = 0; i < 16; ++i) {
                const v4u p0 = *(const v4u*)(Pb + (r0 + i) * 1024 + col); const v4u sv = *(const v4u*)(Sb + (r0 + i) * 1024 + col);
                v4u o;
#pragma unroll
                for (int e = 0; e < 4; ++e) {
                    const float ylo = bf_lo(sv[e]) * (w0[2 * e] * bf_lo(pm2[e]) + w1[2 * e] * bf_lo(pm1[e]) + w2[2 * e] * bf_lo(p0[e]) + bb[2 * e]);
                    const float yhi = bf_hi(sv[e]) * (w0[2 * e + 1] * bf_hi(pm2[e]) + w1[2 * e + 1] * bf_hi(pm1[e]) + w2[2 * e + 1] * bf_hi(p0[e]) + bb[2 * e + 1]);
                    o[e] = cvt_pk_bf16(ylo, yhi); }
                *(v4u*)(Sb + (r0 + i) * 1024 + col) = o;
                pm2 = pm1; pm1 = p0;
            }
        }
    }
}

constexpr int PB_W = 0, PB_Q = 64 * 272, PB_K = 2 * 64 * 272, PB_A = 3 * 64 * 272, PB_U = PB_A + 64 * 144, PB_BUF = PB_U + 64 * 144;
static_assert(2 * PB_BUF <= LDS_BYTES - 16, "PB LDS");
DI void pb_phase(const Args& a, LAS unsigned char* lds, int vcu, int G, int tid, int lane, int wave) {
    unsigned char* ws = a.ws;
    bf16* ACT = (bf16*)(ws + WS_ACT); const bf16* Wb = (const bf16*)(ws + WS_HB); const float* EGL = (const float*)(ws + WS_EGL);
    const bf16* ATTN = (const bf16*)a.out;
    const int r = lane & 15, q = lane >> 4;
    for (int unit = blockIdx.x; unit < 2 * BATCH * NH; unit += G) {
        const int half = (unit >> 3) & 1, bh = (unit & 7) + 8 * (unit >> 4), h = bh & 7, b = bh >> 3;
        if (wave >= 4) {
            const int tl = tid - 256;
            v4u st[16];
#define PB_ISSUE(c_) do { const size_t row0_ = (size_t)b * T + (size_t)(c_) * CH; const int item_ = (b * NCH + (c_)) * NH + h; \
                _Pragma("unroll") for (int k = 0; k < 12; ++k) { const int p = tl + 256 * (k & 3), rw = p >> 4, sg_ = p & 15; \
                    const bf16* src = (k < 4 ? Wb : (k < 8 ? (const bf16*)ACT : (const bf16*)(ACT + ACTSZ))) + (row0_ + rw) * 1024 + h * HD + sg_ * 8; st[k] = *(const v4u*)src; } \
                _Pragma("unroll") for (int k = 12; k < 14; ++k) { const int p = tl + 256 * (k - 12); st[k] = *(const v4u*)(ATTN + (size_t)item_ * 4096 + (p >> 3) * 64 + (p & 7) * 8); } \
                _Pragma("unroll") for (int k = 14; k < 16; ++k) { const int p = tl + 256 * (k - 14); st[k] = *(const v4u*)(ACT + 2 * ACTSZ + (row0_ + (p >> 3)) * 1024 + h * HD + 64 * half + (p & 7) * 8); } } while (0)
#define PB_COMMIT(buf_) do { LAS unsigned char* bb_ = lds + (buf_) * PB_BUF; \
                _Pragma("unroll") for (int k = 0; k < 12; ++k) { const int p = tl + 256 * (k & 3), rw = p >> 4, sg_ = p & 15; *(LAS v4u*)(bb_ + (k >> 2) * (64 * 272) + rw * 272 + sg_ * 16) = st[k]; } \
                _Pragma("unroll") for (int k = 12; k < 14; ++k) { const int p = tl + 256 * (k - 12); *(LAS v4u*)(bb_ + PB_A + (p >> 3) * 144 + (p & 7) * 16) = st[k]; } \
                _Pragma("unroll") for (int k = 14; k < 16; ++k) { const int p = tl + 256 * (k - 14); *(LAS v4u*)(bb_ + PB_U + (p >> 3) * 144 + (p & 7) * 16) = st[k]; } } while (0)
            PB_ISSUE(0); PB_COMMIT(0); PB_ISSUE(1);
            __syncthreads();
            for (int c = 0; c < NCH; ++c) {
                if (c + 1 < NCH) PB_COMMIT((c + 1) & 1);
                if (c + 2 < NCH) PB_ISSUE(c + 2);
                __syncthreads();
            }
#undef PB_ISSUE
#undef PB_COMMIT
        } else {
            const int sl = 4 * half + wave;
            const float eglv = (lane < NCH) ? EGL[(b * NCH + lane) * NH + h] : 0.f;
            f32x4 S[8];
#pragma unroll
            for (int tm = 0; tm < 8; ++tm) S[tm] = (f32x4){0.f, 0.f, 0.f, 0.f};
            __syncthreads();
            for (int c = 0; c < NCH; ++c) {
                const size_t row0 = (size_t)b * T + (size_t)c * CH; const int item = (b * NCH + c) * NH + h;
                const LAS unsigned char* bb = lds + (c & 1) * PB_BUF;
                const LAS unsigned char* wp = bb + PB_W + r * 272 + q * 16;
                const LAS unsigned char* qp = bb + PB_Q + r * 272 + q * 16;
                const LAS unsigned char* kp = bb + PB_K + (r >> 1) * 272 + (r & 1) * 128 + q * 16;
                const LAS unsigned char* ap = bb + PB_A + r * 144 + q * 16;
                const LAS bf16* uq = (const LAS bf16*)(bb + PB_U + (4 * q) * 144) + 16 * wave + r;
                const float egl = __int_as_float(__builtin_amdgcn_readlane(__float_as_int(eglv), c));
                bf16x8 Sb[4];
#pragma unroll
                for (int s = 0; s < 4; ++s) { v4u w; w.x = cvt_pk_bf16_v(S[2 * s][0], S[2 * s][1]); w.y = cvt_pk_bf16_v(S[2 * s][2], S[2 * s][3]); w.z = cvt_pk_bf16_v(S[2 * s + 1][0], S[2 * s + 1][1]); w.w = cvt_pk_bf16_v(S[2 * s + 1][2], S[2 * s + 1][3]);
                    Sb[s] = __builtin_bit_cast(bf16x8, w); }
                f32x4 vn[4], O[4];
#pragma unroll
                for (int t = 0; t < 4; ++t) {
                    f32x4 p = {0.f, 0.f, 0.f, 0.f}, o = {0.f, 0.f, 0.f, 0.f};
#pragma unroll
                    for (int s = 0; s < 4; ++s) { const bf16x8 wf = *(const LAS bf16x8*)(wp + t * (16 * 272) + s * 64); const bf16x8 qf = *(const LAS bf16x8*)(qp + t * (16 * 272) + s * 64);
                        p = MFMA16(wf, Sb[s], p); o = MFMA16(qf, Sb[s], o); }
#pragma unroll
                    for (int e = 0; e < 4; ++e) vn[t][e] = __uint_as_float((unsigned)uq[(16 * t + e) * 72] << 16) - p[e];
                    O[t] = o;
                }
                bf16x8 vb[2];
#pragma unroll
                for (int s = 0; s < 2; ++s) { v4u w; w.x = cvt_pk_bf16_v(vn[2 * s][0], vn[2 * s][1]); w.y = cvt_pk_bf16_v(vn[2 * s][2], vn[2 * s][3]); w.z = cvt_pk_bf16_v(vn[2 * s + 1][0], vn[2 * s + 1][1]); w.w = cvt_pk_bf16_v(vn[2 * s + 1][2], vn[2 * s + 1][3]);
                    vb[s] = __builtin_bit_cast(bf16x8, w); }
#pragma unroll
                for (int t = 0; t < 4; ++t) {
#pragma unroll
                    for (int s = 0; s < 2; ++s) { const bf16x8 af = *(const LAS bf16x8*)(ap + t * (16 * 144) + s * 64); O[t] = MFMA16(af, vb[s], O[t]); }
                }
#pragma unroll
                for (int tm = 0; tm < 8; ++tm) {
                    f32x4 acc = S[tm] * egl;
#pragma unroll
                    for (int s = 0; s < 2; ++s) { const bf16x8 kf = *(const LAS bf16x8*)(kp + tm * (8 * 272) + s * 64); acc = MFMA16(kf, vb[s], acc); }
                    S[tm] = acc;
                }
                bf16* up = ACT + 2 * ACTSZ + (row0 + 4 * q) * 1024 + h * HD + 16 * sl + r;
#pragma unroll
                for (int t = 0; t < 4; ++t)
#pragma unroll
                    for (int e = 0; e < 4; ++e) up[(size_t)(16 * t + e) * 1024] = (bf16)(cvt_pk_bf16_v(O[t][e], 0.f) & 0xffffu);
                __syncthreads();
            }
        }
    }
}

DI void pg_phase(const Args& a, int G, int tid) {
    unsigned char* ws = a.ws; const float* gw = a.in[6];
    bf16* ACT = (bf16*)(ws + WS_ACT); bf16* Ob = ACT + 2 * ACTSZ; const bf16* Zb = ACT + 3 * ACTSZ;
    const size_t total = (size_t)M * 128, stride = (size_t)G * 512;
    const int dv0 = (tid & 15) * 8;
    const f32x4 g0 = *(const f32x4*)(gw + dv0), g1 = *(const f32x4*)(gw + dv0 + 4);
    const float gg[8] = {g0.x, g0.y, g0.z, g0.w, g1.x, g1.y, g1.z, g1.w};
    for (size_t base = (size_t)blockIdx.x * 512 + tid; base < total; base += 8 * stride) {
        v4u ov[8], zv[8];
#pragma unroll
        for (int u = 0; u < 8; ++u) { const size_t idx = base + u * stride; if (idx < total) { const size_t m = idx >> 7; const int cgp = (int)(idx & 127);
            ov[u] = *(const v4u*)(Ob + m * 1024 + cgp * 8); zv[u] = *(const v4u*)(Zb + m * 1024 + cgp * 8); } }
#pragma unroll
        for (int u = 0; u < 8; ++u) { const size_t idx = base + u * stride; if (idx < total) { const size_t m = idx >> 7; const int cgp = (int)(idx & 127);
            float of[8], ss = 0.f;
#pragma unroll
            for (int e = 0; e < 4; ++e) { of[2 * e] = bf_lo(ov[u][e]); of[2 * e + 1] = bf_hi(ov[u][e]); ss += of[2 * e] * of[2 * e] + of[2 * e + 1] * of[2 * e + 1]; }
            ss = row16_sum(ss);
            const float rstd = __builtin_amdgcn_rsqf(ss * (1.f / HD) + EPS);
            v4u o;
#pragma unroll
            for (int e = 0; e < 4; ++e) o[e] = cvt_pk_bf16(of[2 * e] * rstd * gg[2 * e] * bf_lo(zv[u][e]), of[2 * e + 1] * rstd * gg[2 * e + 1] * bf_hi(zv[u][e]));
            *(v4u*)(Ob + m * 1024 + cgp * 8) = o; } }
    }
}

DI void p6_phase(const Args& a, int vcu, int G, int lane, int wave) {
    const float* fw = a.in[10];
    const int gw = vcu * NWAVES + wave, NGW = G * NWAVES;
    f32x4 w[4];
#pragma unroll
    for (int j = 0; j < 4; ++j) w[j] = ((const f32x4*)fw)[lane + 64 * j];
    for (int m = gw; m < M; m += 4 * NGW) {
        f32x4 v[4][4];
#pragma unroll
        for (int u = 0; u < 4; ++u) { const int mm = m + u * NGW; if (mm < M) { const f32x4* yr = (const f32x4*)(a.out + (size_t)mm * D) + lane;
#pragma unroll
            for (int j = 0; j < 4; ++j) v[u][j] = yr[64 * j]; } }
#pragma unroll
        for (int u = 0; u < 4; ++u) { const int mm = m + u * NGW; if (mm < M) { f32x4* yr = (f32x4*)(a.out + (size_t)mm * D) + lane; float s = 0.f;
#pragma unroll
            for (int j = 0; j < 4; ++j) s += (v[u][j].x * v[u][j].x + v[u][j].y * v[u][j].y) + (v[u][j].z * v[u][j].z + v[u][j].w * v[u][j].w);
            const float rstd = 1.f / sqrtf(wave_sum(s) * (1.f / D) + EPS);
#pragma unroll
            for (int j = 0; j < 4; ++j) yr[64 * j] = v[u][j] * rstd * w[j]; } }
    }
}

#ifndef MK_SKIP_GDN
#define MK_SKIP_GDN 0
#endif
__global__ void __launch_bounds__(NWAVES * 64, 2) hybrid_fwd(Args args) {
    extern __shared__ __attribute__((aligned(16))) unsigned char lds_raw[];
    cg::grid_group grid = cg::this_grid();
    LAS unsigned char* lds = (LAS unsigned char*)lds_raw;
    const int tid = threadIdx.x, lane = tid & 63, wave = __builtin_amdgcn_readfirstlane(tid >> 6);
    const int G = gridDim.x, bx = blockIdx.x;
    const int vcu = (G % 8 == 0) ? (bx % 8) * (G / 8) + bx / 8 : bx;
    unsigned char* ws = args.ws;
    bf16* ACT = (bf16*)(ws + WS_ACT);

    volatile LAS unsigned* xst = (volatile LAS unsigned*)(lds + LDS_BYTES - 16);
    if (tid < 4) xst[tid] = 0u;
    __syncthreads();
    if (bx == 0) for (int i = tid; i < XCD_BAR_WORDS; i += NWAVES * 64) ((unsigned*)ws)[i] = 0u;
#ifndef NO_P0
    p0_prologue(args, lds, vcu, G, tid, lane, wave);
#endif
    if (bx == 0 && tid < 64) ((unsigned*)(ws + WS_EGL + 32768))[16 * tid] = 0u;
#ifdef PROBE_P0X2
    __syncthreads();
    p0_prologue(args, lds, vcu, G, tid, lane, wave);
#endif
    grid.sync();
    XcdBarrier xbar = xcd_barrier_post((unsigned*)ws, xst);
    {
        pg8::Gemm g{(const bf16*)(ws + WS_HB), (const bf16*)(ws + WS_WIN), M, N1, D, D, D / 64, 0};
        pg8::StaticOrder S; S.init(M, N1, G, bx);
        pg8::EpiProj E{ACT, (bf16*)(ws + WS_HALO), ACTSZ};
        pg8::gemm_phase<pg8::EpiProj, pg8::StaticOrder, true, true>(lds, g, S, E);
#ifdef PROBE_P1X2
        pg8::gemm_phase<pg8::EpiProj, pg8::StaticOrder, true, true>(lds, g, S, E);
#endif
    }
    xcd_barrier(xbar);
#ifndef NO_PA
    pa_phase(args, lds, G, tid, lane, wave);
#endif
    xcd_barrier(xbar);
#ifndef NO_PB
    pb_phase(args, lds, vcu, G, tid, lane, wave);
#endif
    if (G > 2 * BATCH * NH) { if (bx >= 2 * BATCH * NH) yc_phase(args, 2 * BATCH * NH, G, tid); } else yc_phase(args, 0, G, tid);
    xcd_barrier(xbar);
    pg_phase(args, G, tid);
    xcd_barrier(xbar);
    {
        pg8::Gemm g{ACT + 2 * ACTSZ, (const bf16*)(ws + WS_WOUT), M, D, KMIX, 1024, 16, (long)(3 * ACTSZ * 2)};
        pg8::StaticOrder S; S.init(M, D, G, bx);
        if (G == 256) {
            pg8::EpiResNorm E{args.in[0], args.out, args.in[10], (float*)(ws + WS_SSQ), (unsigned*)(ws + WS_EGL + 32768), D, EPS};
            pg8::gemm_phase<pg8::EpiResNorm, pg8::StaticOrder, false, true>(lds, g, S, E);
        } else {
            pg8::EpiRes E{args.in[0], args.out, D};
            pg8::gemm_phase<pg8::EpiRes, pg8::StaticOrder, true, true>(lds, g, S, E);
            grid.sync();
            p6_phase(args, vcu, G, lane, wave);
        }
    }
}

extern "C" void kernel_launch(void* const* d_in, const int* in_sizes, int n_in, void* d_out, int out_size, void* d_ws, size_t ws_size, hipStream_t stream) {
    static int grid = 0;
    if (grid == 0) {
        if (n_in != 11 || in_sizes[0] != M * D || out_size != M * D || ws_size < WS_END) { fprintf(stderr, "kernel_launch: unexpected shapes (n_in %d, in0 %d, out %d, ws %zu)\n", n_in, n_in > 0 ? in_sizes[0] : -1, out_size, ws_size); grid = -1; return; }
        int dev = 0, cus = 0, per_cu = 0;
        if (hipGetDevice(&dev) != hipSuccess || hipDeviceGetAttribute(&cus, hipDeviceAttributeMultiprocessorCount, dev) != hipSuccess) { grid = -1; return; }
        if (hipFuncSetAttribute((const void*)hybrid_fwd, hipFuncAttributeMaxDynamicSharedMemorySize, LDS_BYTES) != hipSuccess) { fprintf(stderr, "kernel_launch: hipFuncSetAttribute failed\n"); grid = -1; return; }
        if (hipOccupancyMaxActiveBlocksPerMultiprocessor(&per_cu, (const void*)hybrid_fwd, NWAVES * 64, LDS_BYTES) != hipSuccess || per_cu < 1) { fprintf(stderr, "kernel_launch: occupancy query gave %d\n", per_cu); (void)hipGetLastError(); per_cu = 1; }
        grid = cus * 1;
        if (grid > cus * per_cu) grid = cus * per_cu;
    }
    if (grid < 0) return;
    Args a{};
    for (int i = 0; i < 11; ++i) a.in[i] = (const float*)d_in[i];
    a.out = (float*)d_out; a.ws = (unsigned char*)d_ws;
    void* kargs[] = {&a};
    hipError_t e = hipLaunchCooperativeKernel((const void*)hybrid_fwd, dim3(grid), dim3(NWAVES * 64), kargs, LDS_BYTES, stream);
    if (e != hipSuccess) fprintf(stderr, "kernel_launch: cooperative launch failed: %s (grid %d)\n", hipGetErrorString(e), grid);
}
```
